# Optimizing an MI355X kernel written in HIP

```python
import jax, jax.numpy as jnp
from jax import lax
import numpy as np

D_MODEL = 1024
BATCH = 16
SEQ = 2048
DEPTH = 2
DEC_BATCH = 128
DEC_SEQ = 4
PAST_LEN = 8192
PAGE_SIZE = 128

N_HEADS = 8
NOPE_DIM = 64
ROPE_DIM = 32
V_DIM = 64
Q_LORA = 256
KV_LORA = 128
MLA_WIDTH = N_HEADS * V_DIM
GM_GROUPS = 8
GM_HEAD_DIM = 64
GM_WIDTH = GM_GROUPS * GM_HEAD_DIM
CHUNK = 128
IN_WIDTH = Q_LORA + KV_LORA + ROPE_DIM + 2 * GM_WIDTH
D_FF = 4 * D_MODEL
ROPE_THETA = 10000.0
EPS = 1e-6
Q_BLOCK = 128
ATTN_SCALE = (NOPE_DIM + ROPE_DIM) ** -0.5
NEG_INF = -1e30

kernel_name = "hybrid_mla_chunk_gmlp_decode_step"


def rmsnorm(x, g):
    xf = x.astype(jnp.float32)
    y = xf * lax.rsqrt(jnp.mean(xf * xf, axis=-1, keepdims=True) + EPS)
    return (y * g.astype(jnp.float32)).astype(x.dtype)


def rope(x, pos):
    half = ROPE_DIM // 2
    freqs = ROPE_THETA ** (-jnp.arange(half, dtype=jnp.float32) / half)
    ang = pos.astype(jnp.float32)[:, None] * freqs[None, :]
    cos = jnp.cos(ang)[None, :, None, :]
    sin = jnp.sin(ang)[None, :, None, :]
    x1 = x[..., :half].astype(jnp.float32)
    x2 = x[..., half:].astype(jnp.float32)
    out = jnp.concatenate([x1 * cos - x2 * sin, x2 * cos + x1 * sin], axis=-1)
    return out.astype(x.dtype)


def project(h, pos, w_in, q_norm, w_uq, kv_norm, w_uk, v_norm):
    z = jnp.einsum('btd,de->bte', h, w_in)
    s1 = Q_LORA
    s2 = s1 + KV_LORA
    s3 = s2 + ROPE_DIM
    s4 = s3 + GM_WIDTH
    q_lat, c_kv, k_pe, u, v = jnp.split(z, [s1, s2, s3, s4], axis=-1)
    q = jnp.einsum('btr,rhe->bthe', rmsnorm(q_lat, q_norm), w_uq)
    q_nope, q_pe = q[..., :NOPE_DIM], q[..., NOPE_DIM:]
    q_pe = rope(q_pe, pos)
    q_abs = jnp.einsum('bthn,chn->bthc', q_nope, w_uk)
    c_kv = rmsnorm(c_kv, kv_norm)
    k_pe = rope(k_pe[:, :, None, :], pos)[:, :, 0, :]
    v = rmsnorm(v, v_norm)
    return q_abs, q_pe, c_kv, k_pe, u, v


def latent_attention(q_abs, q_pe, c_kv, k_pe, q_pos, k_pos, w_uv):
    s = (jnp.einsum('bqhc,bkc->bhqk', q_abs, c_kv, preferred_element_type=jnp.float32)
         + jnp.einsum('bqhr,bkr->bhqk', q_pe, k_pe, preferred_element_type=jnp.float32)) * ATTN_SCALE
    mask = k_pos[None, :] <= q_pos[:, None]
    s = jnp.where(mask[None, None], s, NEG_INF)
    p = jax.nn.softmax(s, axis=-1).astype(c_kv.dtype)
    o_lat = jnp.einsum('bhqk,bkc->bqhc', p, c_kv)
    o = jnp.einsum('bqhc,chv->bqhv', o_lat, w_uv)
    return o.reshape(o.shape[0], o.shape[1], MLA_WIDTH)


def prompt_attention(q_abs, q_pe, c_kv, k_pe, w_uv):
    B, T = q_abs.shape[0], q_abs.shape[1]
    nb = T // Q_BLOCK
    qa = q_abs.reshape(B, nb, Q_BLOCK, N_HEADS, KV_LORA).transpose(1, 0, 2, 3, 4)
    qp = q_pe.reshape(B, nb, Q_BLOCK, N_HEADS, ROPE_DIM).transpose(1, 0, 2, 3, 4)
    k_pos = jnp.arange(T, dtype=jnp.int32)

    def one_block(args):
        qa_b, qp_b, i = args
        q_pos = i * Q_BLOCK + jnp.arange(Q_BLOCK, dtype=jnp.int32)
        return latent_attention(qa_b, qp_b, c_kv, k_pe, q_pos, k_pos, w_uv)

    o = lax.map(one_block, (qa, qp, jnp.arange(nb, dtype=jnp.int32)))
    return o.transpose(1, 0, 2, 3).reshape(B, T, MLA_WIDTH)


def chunk_gating(u, v, w_s, b_s):
    B, T = u.shape[0], u.shape[1]
    n_chunks = -(-T // CHUNK)
    pad = n_chunks * CHUNK - T
    vp = jnp.pad(v, ((0, 0), (0, pad), (0, 0))).reshape(B, n_chunks, CHUNK, GM_GROUPS, GM_HEAD_DIM)
    w = w_s * jnp.tril(jnp.ones((CHUNK, CHUNK), dtype=w_s.dtype))
    mixed = jnp.einsum('gij,bnjgd->bnigd', w, vp) + b_s.T[None, None, :, :, None]
    mixed = mixed.reshape(B, n_chunks * CHUNK, GM_WIDTH)[:, :T]
    return u * mixed


def trunk_layer(x, pos, attend, nm_pre, nm_post, w_in, q_norm, w_uq, kv_norm, w_uk, w_uv,
                v_norm, w_s, b_s, w_out, nf_pre, nf_post, w_up, w_down):
    h = rmsnorm(x, nm_pre)
    q_abs, q_pe, c_kv, k_pe, u, v = project(h, pos, w_in, q_norm, w_uq, kv_norm, w_uk, v_norm)
    a_out = attend(q_abs, q_pe, c_kv, k_pe, w_uv)
    g_out = chunk_gating(u, v, w_s, b_s)
    mix = jnp.einsum('bte,ed->btd', jnp.concatenate([a_out, g_out], axis=-1), w_out)
    x = x + rmsnorm(mix, nm_post)
    hf = jnp.einsum('btd,df->btf', rmsnorm(x, nf_pre), w_up)
    f = jnp.einsum('btf,fd->btd', jnp.square(jax.nn.relu(hf)), w_down)
    x = x + rmsnorm(f, nf_post)
    return x, c_kv, k_pe, v


def setup_inputs(seed: int = 0) -> dict:
    key = jax.random.key(seed)
    ks = jax.random.split(key, 24)
    n_pages = PAST_LEN // PAGE_SIZE
    n_phys = (DEC_BATCH * n_pages * 5) // 4
    f32 = jnp.float32

    def nrm(k, shape, scale=1.0):
        return jax.random.normal(k, shape, f32) * scale

    def gain(k, shape):
        return 1.0 + 0.1 * jax.random.normal(k, shape, f32)

    page_table = jax.random.permutation(ks[4], n_phys)[:DEC_BATCH * n_pages]
    page_table = page_table.reshape(DEC_BATCH, n_pages).astype(jnp.int32)
    return {
        "x_prompt": nrm(ks[0], (BATCH, SEQ, D_MODEL)),
        "x_sample": nrm(ks[1], (DEC_BATCH, DEC_SEQ, D_MODEL)),
        "cache_kv_latent": nrm(ks[2], (DEPTH, n_phys, PAGE_SIZE, KV_LORA)),
        "cache_k_rope": nrm(ks[3], (DEPTH, n_phys, PAGE_SIZE, ROPE_DIM)),
        "page_table": page_table,
        "norm_mix_pre": gain(ks[5], (DEPTH, D_MODEL)),
        "norm_mix_post": gain(ks[6], (DEPTH, D_MODEL)),
        "w_in": nrm(ks[7], (DEPTH, D_MODEL, IN_WIDTH), D_MODEL ** -0.5),
        "q_norm": gain(ks[8], (DEPTH, Q_LORA)),
        "w_uq": nrm(ks[9], (DEPTH, Q_LORA, N_HEADS, NOPE_DIM + ROPE_DIM), Q_LORA ** -0.5),
        "kv_norm": gain(ks[10], (DEPTH, KV_LORA)),
        "w_uk": nrm(ks[11], (DEPTH, KV_LORA, N_HEADS, NOPE_DIM), KV_LORA ** -0.5),
        "w_uv": nrm(ks[12], (DEPTH, KV_LORA, N_HEADS, V_DIM), KV_LORA ** -0.5),
        "v_norm": gain(ks[13], (DEPTH, GM_WIDTH)),
        "w_spatial": nrm(ks[14], (DEPTH, GM_GROUPS, CHUNK, CHUNK), CHUNK ** -0.5),
        "b_spatial": gain(ks[15], (DEPTH, GM_GROUPS, CHUNK)),
        "w_out": nrm(ks[16], (DEPTH, MLA_WIDTH + GM_WIDTH, D_MODEL), (MLA_WIDTH + GM_WIDTH) ** -0.5),
        "norm_ffn_pre": gain(ks[17], (DEPTH, D_MODEL)),
        "norm_ffn_post": gain(ks[18], (DEPTH, D_MODEL)),
        "w_ff_up": nrm(ks[19], (DEPTH, D_MODEL, D_FF), D_MODEL ** -0.5),
        "w_ff_down": nrm(ks[20], (DEPTH, D_FF, D_MODEL), D_FF ** -0.5),
    }


def reference(x_prompt, x_sample, cache_kv_latent, cache_k_rope, page_table,
              norm_mix_pre, norm_mix_post, w_in, q_norm, w_uq, kv_norm, w_uk, w_uv,
              v_norm, w_spatial, b_spatial, w_out, norm_ffn_pre, norm_ffn_post,
              w_ff_up, w_ff_down):
    B, T = x_prompt.shape[0], x_prompt.shape[1]
    DB, DT = x_sample.shape[0], x_sample.shape[1]
    past_len = page_table.shape[1] * PAGE_SIZE
    pos_prompt = jnp.arange(T, dtype=jnp.int32)
    pos_sample = past_len + jnp.arange(DT, dtype=jnp.int32)

    xp, xs = x_prompt, x_sample
    ckv_p, kpe_p, ckv_s, kpe_s, v_s = [], [], [], [], []
    for l in range(DEPTH):
        weights = (norm_mix_pre[l], norm_mix_post[l], w_in[l], q_norm[l], w_uq[l], kv_norm[l],
                   w_uk[l], w_uv[l], v_norm[l], w_spatial[l], b_spatial[l], w_out[l],
                   norm_ffn_pre[l], norm_ffn_post[l], w_ff_up[l], w_ff_down[l])

        xp, c_p, k_p, _ = trunk_layer(xp, pos_prompt, prompt_attention, *weights)

        past_c = cache_kv_latent[l][page_table].reshape(DB, past_len, KV_LORA)
        past_k = cache_k_rope[l][page_table].reshape(DB, past_len, ROPE_DIM)
        k_pos = jnp.arange(past_len + DT, dtype=jnp.int32)

        def sample_attention(q_abs, q_pe, c_kv, k_pe, w_uv_l, past_c=past_c, past_k=past_k, k_pos=k_pos):
            keys_c = jnp.concatenate([past_c, c_kv], axis=1)
            keys_k = jnp.concatenate([past_k, k_pe], axis=1)
            return latent_attention(q_abs, q_pe, keys_c, keys_k, pos_sample, k_pos, w_uv_l)

        xs, c_s, k_s, vrows = trunk_layer(xs, pos_sample, sample_attention, *weights)

        ckv_p.append(c_p.reshape(B, T // PAGE_SIZE, PAGE_SIZE, KV_LORA))
        kpe_p.append(k_p.reshape(B, T // PAGE_SIZE, PAGE_SIZE, ROPE_DIM))
        ckv_s.append(c_s)
        kpe_s.append(k_s)
        v_s.append(vrows)

    new_kv_latent_prompt = jnp.stack(ckv_p, axis=0)
    new_k_rope_prompt = jnp.stack(kpe_p, axis=0)
    new_kv_latent_sample = jnp.stack(ckv_s, axis=0)
    new_k_rope_sample = jnp.stack(kpe_s, axis=0)
    new_chunk_v_sample = jnp.stack(v_s, axis=0)
    return (xp, xs, new_kv_latent_prompt, new_k_rope_prompt, new_kv_latent_sample, new_k_rope_sample, new_chunk_v_sample)
```

```cpp
#include <hip/hip_runtime.h>
#include <cstdio>
#include <cstdint>
#ifndef MK_ONE_LAUNCH
#define MK_ONE_LAUNCH 1
#endif
namespace pg8 {
#define PG8_LAS __attribute__((address_space(3)))
typedef unsigned short bf16_t;
typedef short bf16x8 __attribute__((ext_vector_type(8)));
typedef float f32x4 __attribute__((ext_vector_type(4)));
typedef unsigned u32x4 __attribute__((ext_vector_type(4)));
constexpr int BM = 256, BK = 64, HALF = 128, HTB = HALF * BK * 2  , STAGE_BYTES = 8 * HTB, NXCD = 8, WGM = 8;

__host__ __device__ __forceinline__ int lds_byte(int r, int c) { const int st = (r >> 4) * 2 + (c >> 5), rr = r & 15, cc = c & 31, ob = rr * 64 + cc * 2; return st * 1024 + (ob ^ (((ob >> 9) & 1) << 5)); }
__host__ __device__ __forceinline__ void stage_rc(int b, int& R, int& C) { const int st = b / 1024, sb = b % 1024, swz = sb ^ (((sb >> 9) & 1) << 5); R = (st >> 1) * 16 + swz / 64; C = (st & 1) * 32 + (swz % 64) / 2; }
__host__ __device__ __forceinline__ int perm32(int rho) { const int n = rho >> 4, i = rho & 15; return 8 * (i >> 2) + 4 * n + (i & 3); }

struct Unit { int pm, pn; };
struct Gemm { const bf16_t* A; const bf16_t* Bt; int lda, ldb, K; };

struct StaticOrder {
    int nM, nN, nwg, G, c;
    __host__ __device__ void init(int nM_, int nN_, int G_, int c_) { nM = nM_; nN = nN_; nwg = nM * nN; G = G_; c = c_; }
    __host__ __device__ bool next(int i, Unit& u) const {
        const long L = (long)i * G + c; if (L >= nwg) return false;
        int wgid = (int)L; { const int q = nwg / NXCD, r = nwg % NXCD, xcd = wgid % NXCD, off = wgid / NXCD; wgid = (xcd < r ? xcd * (q + 1) : r * (q + 1) + (xcd - r) * q) + off; }
        const int nig = WGM * nN, gid = wgid / nig, fm = gid * WGM, gsz = (nM - fm) < WGM ? (nM - fm) : WGM;
        u.pm = fm + ((wgid % nig) % gsz); u.pn = (wgid % nig) / gsz; return true;
    }
    __device__ __forceinline__ void a_ready(const Unit&) const {}
    __device__ __forceinline__ void done(const Unit&) const {}
};

__device__ __forceinline__ unsigned cvt_pk_bf16(float lo, float hi) { unsigned r; asm volatile("v_cvt_pk_bf16_f32 %0, %1, %2" : "=v"(r) : "v"(lo), "v"(hi)); return r; }

template <int ACT  > struct EpiBf16 {
    static constexpr bool PERM = true, AFTER_DRAIN = false;
    bf16_t* O; int ldc; const float* rs;
    __device__ __forceinline__ void operator()(const f32x4 (&acc)[2][2][4][2], const Unit& u, int wr, int wc, int fr, int fq) const {
        const int row0 = u.pm * BM + wr * 64 + fr; const int col0 = u.pn * BM + wc * 32 + 8 * fq;
#pragma unroll
        for (int ai = 0; ai < 2; ++ai)
#pragma unroll
            for (int m = 0; m < 4; ++m) { bf16_t* rowp = O + (size_t)(row0 + ai * HALF + m * 16) * ldc + col0; const float rsc = rs ? rs[row0 + ai * HALF + m * 16] : 1.0f;
#pragma unroll
                for (int bj = 0; bj < 2; ++bj) { f32x4 v0 = acc[ai][bj][m][0] * rsc, v1 = acc[ai][bj][m][1] * rsc;
                    if (ACT == 2) {
#pragma unroll
                        for (int e = 0; e < 4; ++e) { float a = v0[e] > 0.f ? v0[e] : 0.f; v0[e] = a * a; float b = v1[e] > 0.f ? v1[e] : 0.f; v1[e] = b * b; } }
                    u32x4 w; w.x = cvt_pk_bf16(v0[0], v0[1]); w.y = cvt_pk_bf16(v0[2], v0[3]); w.z = cvt_pk_bf16(v1[0], v1[1]); w.w = cvt_pk_bf16(v1[2], v1[3]);
                    *(u32x4*)(rowp + bj * HALF) = w; } }
    }
};

struct EpiZ {
    static constexpr bool PERM = true, AFTER_DRAIN = false;
    bf16_t* O; int ldc; float* ssq; float* ssv;
    __device__ __forceinline__ void operator()(const f32x4 (&acc)[2][2][4][2], const Unit& u, int wr, int wc, int fr, int fq) const {
        const int row0 = u.pm * BM + wr * 64 + fr; const int col0 = u.pn * BM + wc * 32 + 8 * fq;
        const bool doq = u.pn == 0, dov = u.pn >= 4;
#pragma unroll
        for (int ai = 0; ai < 2; ++ai)
#pragma unroll
            for (int m = 0; m < 4; ++m) { const int row = row0 + ai * HALF + m * 16; bf16_t* rowp = O + (size_t)row * ldc + col0; float s = 0.f;
#pragma unroll
                for (int bj = 0; bj < 2; ++bj) { const f32x4 v0 = acc[ai][bj][m][0], v1 = acc[ai][bj][m][1];
                    s += (v0[0] * v0[0] + v0[1] * v0[1]) + (v0[2] * v0[2] + v0[3] * v0[3]) + (v1[0] * v1[0] + v1[1] * v1[1]) + (v1[2] * v1[2] + v1[3] * v1[3]);
                    u32x4 w; w.x = cvt_pk_bf16(v0[0], v0[1]); w.y = cvt_pk_bf16(v0[2], v0[3]); w.z = cvt_pk_bf16(v1[0], v1[1]); w.w = cvt_pk_bf16(v1[2], v1[3]);
                    *(u32x4*)(rowp + bj * HALF) = w; }
                if (doq || dov) { s += __shfl_xor(s, 16); s += __shfl_xor(s, 32);
                    if (fq == 0) { float* d = doq ? ssq + (size_t)row * 4 + wc : ssv + (size_t)row * 8 + (u.pn - 4) * 4 + wc; *d = s; } } }
    }
};

struct EpiQ {
    static constexpr bool PERM = true, AFTER_DRAIN = false;
    bf16_t* Qn; bf16_t* Qr; const float* tab; float sc; int tmask; const float* ssq;
    __device__ __forceinline__ void operator()(const f32x4 (&acc)[2][2][4][2], const Unit& u, int wr, int wc, int fr, int fq) const {
        const int row0 = u.pm * BM + wr * 64 + fr;
        if (u.pn < 2) {
            const int col0 = u.pn * BM + wc * 32 + 8 * fq;
#pragma unroll
            for (int ai = 0; ai < 2; ++ai)
#pragma unroll
                for (int m = 0; m < 4; ++m) { const int row = row0 + ai * HALF + m * 16; bf16_t* rowp = Qn + (size_t)row * 512 + col0;
                    const f32x4 pq = *(const f32x4*)(ssq + (size_t)row * 4); const float scr = sc / sqrtf(((pq[0] + pq[1]) + (pq[2] + pq[3])) * (1.0f / 256.0f) + 1e-6f);
#pragma unroll
                    for (int bj = 0; bj < 2; ++bj) { const f32x4 v0 = acc[ai][bj][m][0] * scr, v1 = acc[ai][bj][m][1] * scr;
                        u32x4 w; w.x = cvt_pk_bf16(v0[0], v0[1]); w.y = cvt_pk_bf16(v0[2], v0[3]); w.z = cvt_pk_bf16(v1[0], v1[1]); w.w = cvt_pk_bf16(v1[2], v1[3]);
                        *(u32x4*)(rowp + bj * HALF) = w; } }
        } else {
            const int col0 = wc * 32 + 8 * fq;
#pragma unroll
            for (int ai = 0; ai < 2; ++ai)
#pragma unroll
                for (int m = 0; m < 4; ++m) { const int row = row0 + ai * HALF + m * 16; bf16_t* rowp = Qr + (size_t)row * 256 + col0;
                    const f32x4* tp = (const f32x4*)(tab + (size_t)(row & tmask) * 32 + 8 * fq);
                    const f32x4 t0 = tp[0], t1 = tp[1];
                    const f32x4 pq = *(const f32x4*)(ssq + (size_t)row * 4); const float sc = this->sc / sqrtf(((pq[0] + pq[1]) + (pq[2] + pq[3])) * (1.0f / 256.0f) + 1e-6f);
#pragma unroll
                    for (int bj = 0; bj < 2; ++bj) { const f32x4 v0 = acc[ai][bj][m][0], v1 = acc[ai][bj][m][1];
                        const float a0 = (v0[0] * t0[0] - v0[1] * t0[1]) * sc, a1 = (v0[1] * t0[0] + v0[0] * t0[1]) * sc;
                        const float a2 = (v0[2] * t0[2] - v0[3] * t0[3]) * sc, a3 = (v0[3] * t0[2] + v0[2] * t0[3]) * sc;
                        const float a4 = (v1[0] * t1[0] - v1[1] * t1[1]) * sc, a5 = (v1[1] * t1[0] + v1[0] * t1[1]) * sc;
                        const float a6 = (v1[2] * t1[2] - v1[3] * t1[3]) * sc, a7 = (v1[3] * t1[2] + v1[2] * t1[3]) * sc;
                        u32x4 w; w.x = cvt_pk_bf16(a0, a1); w.y = cvt_pk_bf16(a2, a3); w.z = cvt_pk_bf16(a4, a5); w.w = cvt_pk_bf16(a6, a7);
                        *(u32x4*)(rowp + bj * HALF) = w; }
                    asm volatile("" ::: "memory"); }
        }
    }
};

template <class Epi, class Sched, bool ALIGN_EPI = false, bool SP2 = false>
__device__ __forceinline__ void gemm_phase(PG8_LAS unsigned char* lds, const Gemm g, const Sched& S, const Epi& E, const int tid) {
    const int wid = __builtin_amdgcn_readfirstlane(tid >> 6), lane = tid & 63, wr = wid >> 2, wc = wid & 3, fr = lane & 15, fq = lane >> 4;
    int K_ = g.K; asm volatile("" : "+s"(K_));
    const int K = K_, nt = K / BK;
    unsigned voffA[2], voffB[2];
#pragma unroll
    for (int i = 0; i < 2; ++i) { int R, C; stage_rc(tid * 16 + i * 8192, R, C); const int Rb = Epi::PERM ? ((R & ~31) + perm32(R & 31)) : R;
        voffA[i] = (unsigned)(R * g.lda + C) * 2u; voffB[i] = (unsigned)(Rb * g.ldb + C) * 2u; }
    const size_t kstep = (size_t)(BK * 2);
    const size_t hstepA = (size_t)HALF * g.lda * 2, hstepB = (size_t)HALF * g.ldb * 2;
    const size_t tstepA = 2 * hstepA, tstepB = 2 * hstepB;
    const unsigned ldsw = (unsigned)wid * 1024u;
    const int aoff = lds_byte(wr * 64 + fr, fq * 8), boff = lds_byte(wc * 32 + fr, fq * 8);
#define PG8_SA(b, h) (((b) * 2 + (h)) * HTB)
#define PG8_SB(b, h) ((4 + (b) * 2 + (h)) * HTB)
#define PG8_STAGE(bufoff, gbase, voff) do { _Pragma("unroll") for (int _i = 0; _i < 2; ++_i) \
        __builtin_amdgcn_global_load_lds((const unsigned*)((const char*)(gbase) + (voff)[_i]), (PG8_LAS unsigned*)(lds + (bufoff) + ldsw + _i * 8192), 16, 0, 0); } while (0)
#define PG8_LDA(dst, b, h) do { _Pragma("unroll") for (int m = 0; m < 4; ++m) _Pragma("unroll") for (int k = 0; k < 2; ++k) dst[m][k] = *(const PG8_LAS bf16x8*)(lds + PG8_SA(b, h) + aoff + m * 2048 + k * 1024); } while (0)
#define PG8_LDB(dst, b, h) do { _Pragma("unroll") for (int n = 0; n < 2; ++n) _Pragma("unroll") for (int k = 0; k < 2; ++k) dst[n][k] = *(const PG8_LAS bf16x8*)(lds + PG8_SB(b, h) + boff + n * 2048 + k * 1024); } while (0)
#define PG8_MMA(ai, bj, At, Bt) do { __builtin_amdgcn_s_setprio(1); _Pragma("unroll") for (int m = 0; m < 4; ++m) _Pragma("unroll") for (int n = 0; n < 2; ++n) _Pragma("unroll") for (int k = 0; k < 2; ++k) \
        acc[ai][bj][m][n] = __builtin_amdgcn_mfma_f32_16x16x32_bf16(Bt[n][k], At[m][k], acc[ai][bj][m][n], 0, 0, 0); __builtin_amdgcn_s_setprio(0); } while (0)
#define PG8_WAIT_V(n) asm volatile("s_waitcnt vmcnt(" #n ")" ::: "memory")
#define PG8_WAIT_L(n) asm volatile("s_waitcnt lgkmcnt(" #n ")" ::: "memory")
#define PG8_BAR __builtin_amdgcn_s_barrier()
#define PG8_SCHED __builtin_amdgcn_sched_barrier(0)
    Unit cur, nxt; int ui = 0;
    if (!S.next(0, cur)) return;
    f32x4 acc[2][2][4][2];
#pragma unroll
    for (int a = 0; a < 2; ++a)
#pragma unroll
        for (int b = 0; b < 2; ++b)
#pragma unroll
            for (int m = 0; m < 4; ++m)
#pragma unroll
                for (int n = 0; n < 2; ++n) acc[a][b][m][n] = (f32x4){0.f, 0.f, 0.f, 0.f};
    bf16x8 At[4][2], B0[2][2], B1[2][2];
    const char* cA = (const char*)g.A + (size_t)cur.pm * tstepA; const char* cB = (const char*)g.Bt + (size_t)cur.pn * tstepB;
    S.a_ready(cur);
    if constexpr (SP2) {
        PG8_STAGE(PG8_SB(0, 0), cB, voffB); PG8_STAGE(PG8_SB(0, 1), cB + hstepB, voffB); PG8_STAGE(PG8_SA(0, 0), cA, voffA); PG8_STAGE(PG8_SA(0, 1), cA + hstepA, voffA);
        if (wr == 1) PG8_BAR;
        PG8_WAIT_V(2); PG8_BAR;
        PG8_STAGE(PG8_SB(1, 0), cB + kstep, voffB); PG8_STAGE(PG8_SA(1, 0), cA + kstep, voffA); PG8_STAGE(PG8_SB(1, 1), cB + hstepB + kstep, voffB);
        PG8_WAIT_V(6); PG8_BAR;
    } else {
        PG8_STAGE(PG8_SB(0, 0), cB, voffB); PG8_STAGE(PG8_SA(0, 0), cA, voffA); PG8_STAGE(PG8_SB(0, 1), cB + hstepB, voffB); PG8_STAGE(PG8_SA(0, 1), cA + hstepA, voffA);
        if (wr == 1) PG8_BAR;
        PG8_WAIT_V(4); PG8_BAR;
        PG8_STAGE(PG8_SB(1, 0), cB + kstep, voffB); PG8_STAGE(PG8_SA(1, 0), cA + kstep, voffA); PG8_STAGE(PG8_SB(1, 1), cB + hstepB + kstep, voffB);
        PG8_WAIT_V(6); PG8_BAR;
    }
    for (;;) {
        const bool has_next = S.next(ui + 1, nxt);
        const char* nA = has_next ? (const char*)g.A + (size_t)nxt.pm * tstepA : cA; const char* nB = has_next ? (const char*)g.Bt + (size_t)nxt.pn * tstepB : cB;
#pragma unroll 1
        for (int t = 0; t < nt; t += 2) {
            const bool last = (t == nt - 2);
            const char* a1 = cA + (size_t)(t + 1) * kstep;
            const char* a2 = last ? nA : cA + (size_t)(t + 2) * kstep; const char* b2 = last ? nB : cB + (size_t)(t + 2) * kstep;
            const char* a3 = a2 + kstep; const char* b3 = b2 + kstep;
            if (last && has_next) S.a_ready(nxt);
            if constexpr (SP2) {
            PG8_LDB(B0, 0, 0); PG8_LDB(B1, 0, 1); PG8_SCHED; PG8_LDA(At, 0, 0); PG8_STAGE(PG8_SA(1, 1), a1 + hstepA, voffA);
            PG8_WAIT_V(8); PG8_WAIT_L(0); PG8_BAR; PG8_MMA(0, 0, At, B0); PG8_MMA(0, 1, At, B1); PG8_BAR; PG8_SCHED;
            PG8_LDA(At, 0, 1); PG8_STAGE(PG8_SB(0, 0), b2, voffB); PG8_STAGE(PG8_SB(0, 1), b2 + hstepB, voffB); PG8_STAGE(PG8_SA(0, 0), a2, voffA);
            PG8_WAIT_V(8); PG8_WAIT_L(0); PG8_BAR; PG8_MMA(1, 0, At, B0); PG8_MMA(1, 1, At, B1); PG8_BAR; PG8_SCHED;
            PG8_LDB(B0, 1, 0); PG8_LDB(B1, 1, 1); PG8_SCHED; PG8_LDA(At, 1, 0); PG8_STAGE(PG8_SA(0, 1), a2 + hstepA, voffA);
            PG8_WAIT_V(8); PG8_WAIT_L(0); PG8_BAR; PG8_MMA(0, 0, At, B0); PG8_MMA(0, 1, At, B1); PG8_BAR; PG8_SCHED;
            PG8_LDA(At, 1, 1); PG8_STAGE(PG8_SB(1, 0), b3, voffB); PG8_STAGE(PG8_SB(1, 1), b3 + hstepB, voffB); PG8_STAGE(PG8_SA(1, 0), a3, voffA);
            PG8_WAIT_V(8); PG8_WAIT_L(0); PG8_BAR; PG8_MMA(1, 0, At, B0); PG8_MMA(1, 1, At, B1); PG8_BAR; PG8_SCHED;
            } else {
            PG8_LDB(B0, 0, 0); PG8_SCHED; PG8_LDA(At, 0, 0); PG8_STAGE(PG8_SA(1, 1), a1 + hstepA, voffA);
            PG8_WAIT_L(8); PG8_BAR; PG8_WAIT_L(0); PG8_MMA(0, 0, At, B0); PG8_BAR; PG8_SCHED;
            PG8_LDB(B1, 0, 1); PG8_STAGE(PG8_SB(0, 0), b2, voffB);
            PG8_BAR; PG8_WAIT_L(0); PG8_MMA(0, 1, At, B1); PG8_BAR;
            PG8_LDA(At, 0, 1); PG8_STAGE(PG8_SA(0, 0), a2, voffA);
            PG8_BAR; PG8_WAIT_L(0); PG8_MMA(1, 0, At, B0); PG8_BAR; PG8_SCHED;
            PG8_STAGE(PG8_SB(0, 1), b2 + hstepB, voffB);
            PG8_WAIT_V(6); PG8_BAR; PG8_MMA(1, 1, At, B1); PG8_BAR;
            PG8_LDB(B0, 1, 0); PG8_SCHED; PG8_LDA(At, 1, 0); PG8_STAGE(PG8_SA(0, 1), a2 + hstepA, voffA);
            PG8_WAIT_L(8); PG8_BAR; PG8_WAIT_L(0); PG8_MMA(0, 0, At, B0); PG8_BAR; PG8_SCHED;
            PG8_LDB(B1, 1, 1); PG8_STAGE(PG8_SB(1, 0), b3, voffB);
            PG8_BAR; PG8_WAIT_L(0); PG8_MMA(0, 1, At, B1); PG8_BAR;
            PG8_LDA(At, 1, 1); PG8_STAGE(PG8_SA(1, 0), a3, voffA);
            PG8_BAR; PG8_WAIT_L(0); PG8_MMA(1, 0, At, B0); PG8_BAR; PG8_SCHED;
            PG8_STAGE(PG8_SB(1, 1), b3 + hstepB, voffB);
            PG8_WAIT_V(6); PG8_BAR; PG8_MMA(1, 1, At, B1); PG8_BAR;
            }
        }
        if constexpr (ALIGN_EPI) { if (wr == 0) PG8_BAR; }
        if constexpr (!Epi::AFTER_DRAIN) { E(acc, cur, wr, wc, fr, fq); S.done(cur); }
        if (!has_next) break;
#pragma unroll
        for (int a = 0; a < 2; ++a)
#pragma unroll
            for (int b = 0; b < 2; ++b)
#pragma unroll
                for (int m = 0; m < 4; ++m)
#pragma unroll
                    for (int n = 0; n < 2; ++n) acc[a][b][m][n] = (f32x4){0.f, 0.f, 0.f, 0.f};
        cur = nxt; cA = nA; cB = nB; ++ui;
        if constexpr (ALIGN_EPI) { if (wr == 1) PG8_BAR; }
    }
    PG8_WAIT_V(0);
    if constexpr (!ALIGN_EPI) { if (wr == 0) PG8_BAR; }
    PG8_BAR;
#undef PG8_SA
#undef PG8_SB
#undef PG8_STAGE
#undef PG8_LDA
#undef PG8_LDB
#undef PG8_MMA
#undef PG8_WAIT_V
#undef PG8_WAIT_L
#undef PG8_BAR
#undef PG8_SCHED
}
}
constexpr int DM = 1024, NB = 16, SEQ = 2048, DEPTH = 2, DB = 128, DT = 4, PAST = 8192, PAGE = 128;
constexpr int NH = 8, NOPE = 64, ROPE = 32, VD = 64, QL = 256, KVL = 128, GMW = 512, CHUNK = 128;
constexpr int INW = 1440, ZW = 1536, DFF = 4096;
constexpr int MP = NB * SEQ, MS = DB * DT, M = MP + MS;
constexpr int NPAGES = PAST / PAGE, NPHYS = (DB * NPAGES * 5) / 4;
constexpr float EPS = 1e-6f;
constexpr float C2 = 0.10206207261596575f * 1.4426950408889634f;
constexpr int NPOS = SEQ + DT;

constexpr size_t O_Y = 0;
constexpr size_t O_CKV_P = (size_t)M * DM;
constexpr size_t O_KR_P = O_CKV_P + (size_t)DEPTH * MP * KVL;
constexpr size_t O_CKV_S = O_KR_P + (size_t)DEPTH * MP * ROPE;
constexpr size_t O_KR_S = O_CKV_S + (size_t)DEPTH * MS * KVL;
constexpr size_t O_V_S = O_KR_S + (size_t)DEPTH * MS * ROPE;
constexpr size_t O_END = O_V_S + (size_t)DEPTH * MS * GMW;

constexpr size_t MiB = 1u << 20;
constexpr size_t WS_CTL = 0, CTL_ZERO_BYTES = 1 * MiB;
constexpr size_t WS_WL = 2 * MiB, WL_STRIDE = 24 * MiB;
constexpr size_t WL_WIN = 0, WL_WUQ = 3 * MiB, WL_WQS = 3 * MiB + 512 * 1024, WL_WKV = 4 * MiB + 256 * 1024, WL_WSP = 4 * MiB + 512 * 1024,
                 WL_WOUT = 5 * MiB, WL_WUP = 7 * MiB, WL_WDN = 15 * MiB;
constexpr size_t WS_ROPE = 50 * MiB;
constexpr size_t WS_SSQ = 60 * MiB, WS_SSV = 61 * MiB;
constexpr size_t WS_RS = 62 * MiB;
constexpr size_t WS_H = 64 * MiB;
constexpr size_t WS_Z = 130 * MiB;
constexpr size_t WS_QN = 228 * MiB, WS_QR = 260 * MiB;
constexpr size_t WS_KV = 276 * MiB;
constexpr size_t WS_QS = 340 * MiB;
constexpr size_t WS_AG = 342 * MiB;
constexpr size_t WS_MIX = 408 * MiB;
constexpr size_t WS_FS = 474 * MiB;
constexpr size_t WS_R = 484 * MiB;
constexpr size_t WS_END = 746 * MiB;

constexpr int CW_TMO = 0, CW_CODE = 1;
constexpr int CW_BAR = 4096;
constexpr int CW_Q = 8192;

constexpr int RING_OFF = 0, RING_BYTES = 131072;
constexpr int LDSCTL_OFF = RING_BYTES, MISC_OFF = LDSCTL_OFF + 320;
constexpr int LDS_BYTES = 147456;

#define GAS __attribute__((address_space(1)))
#define LAS __attribute__((address_space(3)))
typedef unsigned short bf16;
typedef unsigned v4u __attribute__((ext_vector_type(4)));
typedef unsigned v2u __attribute__((ext_vector_type(2)));
typedef float f32x4 __attribute__((ext_vector_type(4)));
typedef float f32x2 __attribute__((ext_vector_type(2)));
typedef float f32x16 __attribute__((ext_vector_type(16)));
typedef short bf16x8 __attribute__((ext_vector_type(8)));
typedef short s16x4 __attribute__((ext_vector_type(4)));
typedef GAS unsigned gu32;
#define RLX_AGENT __ATOMIC_RELAXED, __HIP_MEMORY_SCOPE_AGENT
#define LDS_WAIT() asm volatile("s_waitcnt lgkmcnt(0)" ::: "memory")
#define VM_WAIT() asm volatile("s_waitcnt vmcnt(0)" ::: "memory")
__device__ __forceinline__ unsigned f2bf(float f) { unsigned u = __builtin_bit_cast(unsigned, f); return (u + 0x7fffu + ((u >> 16) & 1u)) >> 16; }
__device__ __forceinline__ unsigned pk2(float lo, float hi) { return f2bf(lo) | (f2bf(hi) << 16); }
__device__ __forceinline__ float bflo(unsigned w) { return __builtin_bit_cast(float, w << 16); }
__device__ __forceinline__ float bfhi(unsigned w) { return __builtin_bit_cast(float, w & 0xffff0000u); }
__device__ __forceinline__ float bf2f(bf16 h) { return __builtin_bit_cast(float, (unsigned)h << 16); }
__device__ __forceinline__ int crow(int r, int hi) { return (r & 3) + 8 * (r >> 2) + 4 * hi; }
__device__ __forceinline__ float wave_sum(float v) {
#pragma unroll
    for (int o = 1; o < 64; o <<= 1) v += __shfl_xor(v, o);
    return v;
}
__device__ __forceinline__ s16x4 vtr(const LAS char* p) { return __builtin_bit_cast(s16x4, __builtin_amdgcn_ds_read_tr16_b64_v4i16((LAS s16x4*)p)); }
__device__ __forceinline__ bf16x8 cat8(s16x4 a, s16x4 b) { return (bf16x8){a[0], a[1], a[2], a[3], b[0], b[1], b[2], b[3]}; }
__device__ __forceinline__ bf16x8 pack8(float a0, float a1, float a2, float a3, float a4, float a5, float a6, float a7) {
    v4u w; w.x = pg8::cvt_pk_bf16(a0, a1); w.y = pg8::cvt_pk_bf16(a2, a3); w.z = pg8::cvt_pk_bf16(a4, a5); w.w = pg8::cvt_pk_bf16(a6, a7); return __builtin_bit_cast(bf16x8, w); }

struct Ptrs {
    const float *x_p, *x_s, *cache_c, *cache_r; const int* ptab;
    const float *nm_pre, *nm_post, *w_in, *q_norm, *w_uq, *kv_norm, *w_uk, *w_uv, *v_norm, *w_sp, *b_sp, *w_out, *nf_pre, *nf_post, *w_up, *w_dn;
    float* out; unsigned char* ws;
};

template <int MODE>
__device__ __forceinline__ int dest_row(int n, int row_off) {
    if (MODE == 0) return row_off + n;
    if (MODE == 1) return n < 416 ? n : n + 96;
    const int h = n / 96, e = n - h * 96;
    if (MODE == 2) return e < 64 ? h * 64 + e : 512 + h * 32 + 2 * ((e - 64) & 15) + ((e - 64) >> 4);
    return e >= 64 ? 1024 + h * 32 + (e - 64) : -1;
}
template <int MODE>
__device__ __forceinline__ void p0_transpose_item(const float* W, int K, int N, bf16* WT, int row_off, LAS float* scr, int item, int lane, const float* gk = nullptr) {
    const int nblk = N / 32, kb = item / nblk, nb = item % nblk, k0 = 64 * kb, n0 = 32 * nb;
    {
        f32x4 w[8];
#pragma unroll
        for (int i = 0; i < 8; ++i) { const int kk = 8 * i + (lane >> 3); w[i] = *(const GAS f32x4*)(W + (size_t)(k0 + kk) * N + n0 + 4 * (lane & 7)); }
#pragma unroll
        for (int i = 0; i < 8; ++i) { const int kk = 8 * i + (lane >> 3); LAS float* d = scr + kk * 33 + 4 * (lane & 7); d[0] = w[i].x; d[1] = w[i].y; d[2] = w[i].z; d[3] = w[i].w; }
    }
    LDS_WAIT(); asm volatile("" ::: "memory");
    const int c = lane & 7;
    float gv[8];
#pragma unroll
    for (int e = 0; e < 8; ++e) gv[e] = gk ? gk[k0 + 8 * c + e] : 1.0f;
#pragma unroll
    for (int j = 0; j < 4; ++j) { const int n = (lane >> 3) + 8 * j; const LAS float* s = scr + (8 * c) * 33 + n;
        const float v0 = s[0 * 33], v1 = s[1 * 33], v2 = s[2 * 33], v3 = s[3 * 33], v4 = s[4 * 33], v5 = s[5 * 33], v6 = s[6 * 33], v7 = s[7 * 33];
        v4u o; o.x = pk2(v0 * gv[0], v1 * gv[1]); o.y = pk2(v2 * gv[2], v3 * gv[3]); o.z = pk2(v4 * gv[4], v5 * gv[5]); o.w = pk2(v6 * gv[6], v7 * gv[7]);
        const int dr = dest_row<MODE>(n0 + n, row_off);
        if (dr >= 0) *(GAS v4u*)(WT + (size_t)dr * K + k0 + 8 * c) = o;
        if (MODE == 2) { const int dr2 = dest_row<3>(n0 + n, 0);
            if (dr2 >= 0) { v4u o2; o2.x = pk2(v0, v1); o2.y = pk2(v2, v3); o2.z = pk2(v4, v5); o2.w = pk2(v6, v7); *(GAS v4u*)(WT + (size_t)(WL_WQS - WL_WUQ) / 2 + (size_t)dr2 * K + k0 + 8 * c) = o2; } } }
    LDS_WAIT(); asm volatile("" ::: "memory");
}

__device__ __forceinline__ void rope_entry(int pos, int i, float& c, float& s) {
    const double f = exp2(-(double)i * (13.287712379549449 / 16.0));
    const double f2 = f * f; double cs = 1.0, sn = f, tc = 1.0, ts = f;
#pragma unroll 1
    for (int k = 1; k <= 12; ++k) { tc *= -f2 / (double)((2 * k - 1) * (2 * k)); ts *= -f2 / (double)((2 * k) * (2 * k + 1)); cs += tc; sn += ts; }
    double rc = 1.0, rs = 0.0, bc = cs, bs = sn; int p = pos;
#pragma unroll 1
    for (int b = 0; b < 14; ++b) { if (p & 1) { const double nc = rc * bc - rs * bs, ns = rc * bs + rs * bc; rc = nc; rs = ns; }
        const double nbc = bc * bc - bs * bs, nbs = 2.0 * bc * bs; bc = nbc; bs = nbs; p >>= 1; }
    c = (float)rc; s = (float)rs;
}

template <int NR>
__device__ __forceinline__ void rows_to_bf16_rs(const float* const (&xrow)[NR], bf16* const (&orow)[NR], float* const (&rs)[NR], const bool (&valid)[NR], int lane) {
    f32x4 v[NR][4];
#pragma unroll
    for (int r = 0; r < NR; ++r) if (valid[r]) {
#pragma unroll
        for (int jj = 0; jj < 2; ++jj) { const GAS f32x4* xr = (const GAS f32x4*)(xrow[r] + jj * 512 + 8 * lane); v[r][2 * jj] = xr[0]; v[r][2 * jj + 1] = xr[1]; } }
#pragma unroll
    for (int r = 0; r < NR; ++r) if (valid[r]) {
        float s = 0.f;
#pragma unroll
        for (int j = 0; j < 4; ++j) s += (v[r][j].x * v[r][j].x + v[r][j].y * v[r][j].y) + (v[r][j].z * v[r][j].z + v[r][j].w * v[r][j].w);
        const float rstd = 1.0f / sqrtf(wave_sum(s) * (1.f / DM) + EPS);
        if (lane == 0) *rs[r] = rstd;
#pragma unroll
        for (int jj = 0; jj < 2; ++jj) { const f32x4 a = v[r][2 * jj] * rstd, b2 = v[r][2 * jj + 1] * rstd;
            v4u o; o.x = pk2(a.x, a.y); o.y = pk2(a.z, a.w); o.z = pk2(b2.x, b2.y); o.w = pk2(b2.z, b2.w);
            *(GAS v4u*)(orow[r] + jj * 512 + 8 * lane) = o; } }
}

template <class Epi>
__device__ __forceinline__ void small_gemm(const bf16* A, int lda, const bf16* Bt, int ldb, int Kper, int ntn, int KS, const Epi& E, int gw, int ngw, int lane) {
    const int r32 = lane & 31, hi = lane >> 5;
    const int nitem = 16 * ntn * KS;
    for (int item = gw; item < nitem; item += ngw) {
        const int tm = item & 15, rest = item >> 4, tn = rest % ntn, ks = rest / ntn;
        const bf16* ap = A + (size_t)(tm * 32 + r32) * lda + ks * Kper + hi * 8;
        const bf16* bp = Bt + (size_t)(tn * 32 + r32) * ldb + ks * Kper + hi * 8;
        f32x16 acc = {};
#pragma unroll 1
        for (int k = 0; k < Kper; k += 128) {
            bf16x8 a[8], b[8];
#pragma unroll
            for (int j = 0; j < 8; ++j) { a[j] = *(const GAS bf16x8*)(ap + k + j * 16); b[j] = *(const GAS bf16x8*)(bp + k + j * 16); }
#pragma unroll
            for (int j = 0; j < 8; ++j) acc = __builtin_amdgcn_mfma_f32_32x32x16_bf16(b[j], a[j], acc, 0, 0, 0);
        }
        E(acc, tm * 32 + r32, tn * 32, ks, hi);
    }
}
template <int ACT> struct SEpiBf16 {
    bf16* O; int ldc; const float* rs;
    __device__ __forceinline__ void operator()(const f32x16& acc, int row, int col0, int ks, int hi) const {
        bf16* rp = O + (size_t)row * ldc + col0 + 4 * hi; const float rsc = rs ? rs[row] : 1.0f;
#pragma unroll
        for (int q = 0; q < 4; ++q) { float v[4];
#pragma unroll
            for (int e = 0; e < 4; ++e) { float x = acc[4 * q + e] * rsc; if (ACT == 2) { x = x > 0.f ? x : 0.f; x = x * x; } v[e] = x; }
            v2u w; w.x = pk2(v[0], v[1]); w.y = pk2(v[2], v[3]); *(GAS v2u*)(rp + 8 * q) = w; }
    }
};
struct SEpiF32Slab {
    float* O;
    __device__ __forceinline__ void operator()(const f32x16& acc, int row, int col0, int ks, int hi) const {
        float* rp = O + ((size_t)ks * MS + row) * DM + col0 + 4 * hi;
#pragma unroll
        for (int q = 0; q < 4; ++q) *(GAS f32x4*)(rp + 8 * q) = (f32x4){acc[4 * q], acc[4 * q + 1], acc[4 * q + 2], acc[4 * q + 3]};
    }
};
struct SEpiQs {
    bf16* O; const float* tab; float sc;
    __device__ __forceinline__ void operator()(const f32x16& acc, int row, int col0, int ks, int hi) const {
        bf16* rp = O + (size_t)row * 1280 + col0 + 4 * hi;
        float v[16];
        if (col0 < 1024) {
#pragma unroll
            for (int r = 0; r < 16; ++r) v[r] = acc[r] * sc;
        } else {
            const float* tp = tab + (size_t)(SEQ + (row & 3)) * 32;
#pragma unroll
            for (int r = 0; r < 8; ++r) { const int i = crow(r, hi); const float c = tp[2 * i], s = tp[2 * i + 1]; const float x1 = acc[r], x2 = acc[r + 8];
                v[r] = (x1 * c - x2 * s) * sc; v[r + 8] = (x2 * c + x1 * s) * sc; }
        }
#pragma unroll
        for (int q = 0; q < 4; ++q) { v2u w; w.x = pk2(v[4 * q], v[4 * q + 1]); w.y = pk2(v[4 * q + 2], v[4 * q + 3]); *(GAS v2u*)(rp + 8 * q) = w; }
    }
};
#define XB_TMO      128
#define XB_XCNT(j)  (256  + 64 * (j))
#define XB_XSUB(j)  (1280 + 64 * (j))
#define XB_XGEN(j)  (2304 + 64 * (j))
#define XB_TOP      3328
#define XB_TOPGEN   3392
#define XCD_BAR_WORDS 3456
#define XB_SPIN_CAP (1u << 18)

__device__ __forceinline__ unsigned xb_ld(unsigned* p)              { return __hip_atomic_load(p, __ATOMIC_RELAXED, __HIP_MEMORY_SCOPE_AGENT); }
__device__ __forceinline__ unsigned xb_add(unsigned* p, unsigned v) { return __hip_atomic_fetch_add(p, v, __ATOMIC_RELAXED, __HIP_MEMORY_SCOPE_AGENT); }
__device__ __forceinline__ unsigned xb_xcc_id() { return (unsigned)__builtin_amdgcn_s_getreg((3 << 11) | 20) & 0xFu; }
#define XB_SPIN(cond, bar) do { unsigned _sp = 0; while (cond) { __builtin_amdgcn_s_sleep(1); \
    if ((++_sp & 255u) == 0u) { if (xb_ld(&(bar)[XB_TMO])) break; if (_sp > XB_SPIN_CAP) { atomicAdd(&(bar)[XB_TMO], 1u); break; } } } } while (0)

struct XcdBarrier {
    unsigned* bar; unsigned x;
    volatile LAS unsigned* st;
};

__device__ __forceinline__ XcdBarrier xcd_barrier_post(unsigned* bar, volatile LAS unsigned* st) {
    XcdBarrier b; b.bar = bar; b.x = xb_xcc_id(); b.st = st;
    if (threadIdx.x == 0) (void)xb_add(&bar[XB_XCNT(b.x)], 1u);
    return b;
}
__device__ __forceinline__ void xcd_barrier_complete(unsigned* bar, unsigned x, unsigned& nloc, unsigned& nx) {
    const unsigned G = gridDim.x * gridDim.y * gridDim.z;
    unsigned sum, cnt, mine, sp = 0u;
    for (;;) {
        sum = 0u; cnt = 0u; mine = 0u;
#pragma unroll
        for (unsigned j = 0; j < 16; ++j) { const unsigned c = xb_ld(&bar[XB_XCNT(j)]); sum += c; cnt += (c > 0u) ? 1u : 0u; mine = (j == x) ? c : mine; }
        if (sum == G) break;
        __builtin_amdgcn_s_sleep(1);
        if ((++sp & 255u) == 0u) { if (xb_ld(&bar[XB_TMO])) break; if (sp > XB_SPIN_CAP) { atomicAdd(&bar[XB_TMO], 1u); break; } }
    }
    nloc = mine > 0u ? mine : 1u; nx = cnt > 0u ? cnt : 1u;
}

__device__ __forceinline__ void xcd_barrier(const XcdBarrier& b) {
    asm volatile("s_waitcnt vmcnt(0)" ::: "memory");
    __syncthreads();
    if (threadIdx.x == 0) {
        unsigned* bar = b.bar;
        __builtin_amdgcn_s_waitcnt(0);
        unsigned nloc = b.st[0], nx = b.st[1];
        if (nloc == 0u) { xcd_barrier_complete(bar, b.x, nloc, nx); b.st[0] = nloc; b.st[1] = nx; }
        const unsigned old = xb_add(&bar[XB_XSUB(b.x)], 1u);
        const unsigned gen = old / nloc;
        if (old + 1u == (gen + 1u) * nloc) {
            __builtin_amdgcn_fence(__ATOMIC_RELEASE, "agent");
            asm volatile("s_waitcnt vmcnt(0)" ::: "memory");
            const unsigned og = xb_add(&bar[XB_TOP], 1u);
            const unsigned tg = og / nx;
            if (og + 1u == (tg + 1u) * nx) xb_add(&bar[XB_TOPGEN], 1u);
            else XB_SPIN(xb_ld(&bar[XB_TOPGEN]) == tg, bar);
            __builtin_amdgcn_fence(__ATOMIC_ACQUIRE, "agent");
            xb_add(&bar[XB_XGEN(b.x)], 1u);
            asm volatile("s_waitcnt vmcnt(0)" ::: "memory");
        } else {
            XB_SPIN(xb_ld(&bar[XB_XGEN(b.x)]) == gen, bar);
            __builtin_amdgcn_fence(__ATOMIC_ACQUIRE, "agent");
            asm volatile("s_waitcnt vmcnt(0)" ::: "memory");
        }
    }
    __syncthreads();
}
__device__ __forceinline__ void postproj_row(const Ptrs& P, int l, int row, int lane) {
    bf16* zr = (bf16*)(P.ws + WS_Z) + (size_t)row * ZW;
    const v2u qw = *(const GAS v2u*)(zr + 4 * lane);
    const unsigned cw = *(const GAS unsigned*)(zr + 256 + 2 * lane);
    const v4u vw = *(const GAS v4u*)(zr + 1024 + 8 * lane);
    float kx1 = 0.f, kx2 = 0.f;
    if (lane < 16) { kx1 = bf2f(zr[384 + lane]); kx2 = bf2f(zr[400 + lane]); }
    const float q0 = bflo(qw.x), q1 = bfhi(qw.x), q2 = bflo(qw.y), q3 = bfhi(qw.y);
    const float c0 = bflo(cw), c1 = bfhi(cw);
    float vv[8] = {bflo(vw.x), bfhi(vw.x), bflo(vw.y), bfhi(vw.y), bflo(vw.z), bfhi(vw.z), bflo(vw.w), bfhi(vw.w)};
    float sq = (q0 * q0 + q1 * q1) + (q2 * q2 + q3 * q3), sc = c0 * c0 + c1 * c1, sv = 0.f;
#pragma unroll
    for (int e = 0; e < 8; ++e) sv += vv[e] * vv[e];
    sq = wave_sum(sq); sc = wave_sum(sc); sv = wave_sum(sv);
    const float rq = 1.0f / sqrtf(sq * (1.f / QL) + EPS), rc = 1.0f / sqrtf(sc * (1.f / KVL) + EPS), rv = 1.0f / sqrtf(sv * (1.f / GMW) + EPS);
    const bool samp = row >= MP; const int rs = row - MP;
    const int pos_idx = samp ? SEQ + (rs & 3) : (row & (SEQ - 1));
    { const f32x4 g = *(const f32x4*)(P.q_norm + l * QL + 4 * lane);
      v2u o; o.x = pk2(q0 * rq * g.x, q1 * rq * g.y); o.y = pk2(q2 * rq * g.z, q3 * rq * g.w); *(GAS v2u*)(zr + 4 * lane) = o; }
    { const f32x2 g = *(const f32x2*)(P.kv_norm + l * KVL + 2 * lane); const float a = c0 * rc * g.x, b = c1 * rc * g.y;
      *(GAS unsigned*)(zr + 256 + 2 * lane) = pk2(a, b);
      float* op = samp ? P.out + O_CKV_S + ((size_t)l * MS + rs) * KVL : P.out + O_CKV_P + ((size_t)l * MP + row) * KVL;
      *(GAS f32x2*)(op + 2 * lane) = (f32x2){a, b}; }
    if (lane < 16) { const f32x2 cs = *(const f32x2*)((const float*)(P.ws + WS_ROPE) + (size_t)pos_idx * 32 + 2 * lane);
      const float y1 = kx1 * cs.x - kx2 * cs.y, y2 = kx2 * cs.x + kx1 * cs.y;
      *(GAS unsigned*)(zr + 384 + 2 * lane) = pk2(y1, y2);
      float* op = samp ? P.out + O_KR_S + ((size_t)l * MS + rs) * ROPE : P.out + O_KR_P + ((size_t)l * MP + row) * ROPE;
      op[lane] = y1; op[16 + lane] = y2; }
    { const f32x4 g0 = *(const f32x4*)(P.v_norm + l * GMW + 8 * lane), g1 = *(const f32x4*)(P.v_norm + l * GMW + 8 * lane + 4);
      const float gg[8] = {g0.x, g0.y, g0.z, g0.w, g1.x, g1.y, g1.z, g1.w};
#pragma unroll
      for (int e = 0; e < 8; ++e) vv[e] = vv[e] * rv * gg[e];
      v4u o; o.x = pk2(vv[0], vv[1]); o.y = pk2(vv[2], vv[3]); o.z = pk2(vv[4], vv[5]); o.w = pk2(vv[6], vv[7]);
      *(GAS v4u*)(zr + 1024 + 8 * lane) = o;
      if (samp) { float* op = P.out + O_V_S + ((size_t)l * MS + rs) * GMW + 8 * lane;
        *(GAS f32x4*)op = (f32x4){vv[0], vv[1], vv[2], vv[3]}; *(GAS f32x4*)(op + 4) = (f32x4){vv[4], vv[5], vv[6], vv[7]}; } }
}

template <int NR>
__device__ __forceinline__ void postproj_rows_ck(const Ptrs& P, int l, const int (&rows)[NR], int lane) {
    unsigned cw[NR]; float kx1[NR], kx2[NR]; f32x2 cs[NR];
#pragma unroll
    for (int r = 0; r < NR; ++r) { if (rows[r] >= MP) continue; bf16* zr = (bf16*)(P.ws + WS_Z) + (size_t)rows[r] * ZW;
        cw[r] = *(const GAS unsigned*)(zr + 256 + 2 * lane); kx1[r] = 0.f; kx2[r] = 0.f; cs[r] = (f32x2){0.f, 0.f};
        if (lane < 16) { kx1[r] = bf2f(zr[384 + lane]); kx2[r] = bf2f(zr[400 + lane]); cs[r] = *(const f32x2*)((const float*)(P.ws + WS_ROPE) + (size_t)(rows[r] & (SEQ - 1)) * 32 + 2 * lane); } }
    const f32x2 g = *(const f32x2*)(P.kv_norm + l * KVL + 2 * lane);
#pragma unroll
    for (int r = 0; r < NR; ++r) { if (rows[r] >= MP) continue; bf16* zr = (bf16*)(P.ws + WS_Z) + (size_t)rows[r] * ZW;
        const float c0 = bflo(cw[r]), c1 = bfhi(cw[r]);
        const float rc = 1.0f / sqrtf(wave_sum(c0 * c0 + c1 * c1) * (1.f / KVL) + EPS);
        const float a = c0 * rc * g.x, b = c1 * rc * g.y;
        *(GAS unsigned*)(zr + 256 + 2 * lane) = pk2(a, b);
        *(GAS f32x2*)(P.out + O_CKV_P + ((size_t)l * MP + rows[r]) * KVL + 2 * lane) = (f32x2){a, b};
        if (lane < 16) { const float y1 = kx1[r] * cs[r].x - kx2[r] * cs[r].y, y2 = kx2[r] * cs[r].x + kx1[r] * cs[r].y;
            *(GAS unsigned*)(zr + 384 + 2 * lane) = pk2(y1, y2);
            float* op = P.out + O_KR_P + ((size_t)l * MP + rows[r]) * ROPE; op[lane] = y1; op[16 + lane] = y2; } }
}

struct RowIO { const float* xold; const bf16* xbold; const bf16* trow; const float* slab; float* xnew; bf16* xb; float* rs; };
template <int NR>
__device__ __forceinline__ void resid_rows(const RowIO (&io)[NR], const bool (&valid)[NR], const float* gpost, int lane) {
    float t[NR][16], x[NR][16];
#pragma unroll
    for (int r = 0; r < NR; ++r) if (valid[r]) {
#pragma unroll
        for (int jj = 0; jj < 2; ++jj) {
            const int c0 = jj * 512 + 8 * lane;
            if (io[r].trow) { const v4u w = __builtin_nontemporal_load((const GAS v4u*)(io[r].trow + c0));
                t[r][8 * jj + 0] = bflo(w.x); t[r][8 * jj + 1] = bfhi(w.x); t[r][8 * jj + 2] = bflo(w.y); t[r][8 * jj + 3] = bfhi(w.y);
                t[r][8 * jj + 4] = bflo(w.z); t[r][8 * jj + 5] = bfhi(w.z); t[r][8 * jj + 6] = bflo(w.w); t[r][8 * jj + 7] = bfhi(w.w);
            } else {
                f32x4 a = {0.f, 0.f, 0.f, 0.f}, b = {0.f, 0.f, 0.f, 0.f};
#pragma unroll
                for (int ks = 0; ks < 4; ++ks) { a += *(const GAS f32x4*)(io[r].slab + (size_t)ks * MS * DM + c0); b += *(const GAS f32x4*)(io[r].slab + (size_t)ks * MS * DM + c0 + 4); }
                t[r][8 * jj + 0] = a.x; t[r][8 * jj + 1] = a.y; t[r][8 * jj + 2] = a.z; t[r][8 * jj + 3] = a.w; t[r][8 * jj + 4] = b.x; t[r][8 * jj + 5] = b.y; t[r][8 * jj + 6] = b.z; t[r][8 * jj + 7] = b.w;
            }
            if (io[r].xold) { const f32x4 xa = __builtin_nontemporal_load((const GAS f32x4*)(io[r].xold + c0)), xb = __builtin_nontemporal_load((const GAS f32x4*)(io[r].xold + c0 + 4));
                x[r][8 * jj + 0] = xa.x; x[r][8 * jj + 1] = xa.y; x[r][8 * jj + 2] = xa.z; x[r][8 * jj + 3] = xa.w; x[r][8 * jj + 4] = xb.x; x[r][8 * jj + 5] = xb.y; x[r][8 * jj + 6] = xb.z; x[r][8 * jj + 7] = xb.w;
            } else { const v4u w = *(const GAS v4u*)(io[r].xbold + c0); const float inv = 1.0f / *(const GAS float*)io[r].rs;
                x[r][8 * jj + 0] = bflo(w.x) * inv; x[r][8 * jj + 1] = bfhi(w.x) * inv; x[r][8 * jj + 2] = bflo(w.y) * inv; x[r][8 * jj + 3] = bfhi(w.y) * inv;
                x[r][8 * jj + 4] = bflo(w.z) * inv; x[r][8 * jj + 5] = bfhi(w.z) * inv; x[r][8 * jj + 6] = bflo(w.w) * inv; x[r][8 * jj + 7] = bfhi(w.w) * inv; }
        }
    }
    float gp[16];
#pragma unroll
    for (int jj = 0; jj < 2; ++jj) { const int c0 = jj * 512 + 8 * lane;
        const f32x4 g0 = *(const f32x4*)(gpost + c0), g1 = *(const f32x4*)(gpost + c0 + 4); gp[8 * jj] = g0.x; gp[8 * jj + 1] = g0.y; gp[8 * jj + 2] = g0.z; gp[8 * jj + 3] = g0.w; gp[8 * jj + 4] = g1.x; gp[8 * jj + 5] = g1.y; gp[8 * jj + 6] = g1.z; gp[8 * jj + 7] = g1.w; }
#pragma unroll
    for (int r = 0; r < NR; ++r) if (valid[r]) {
        float s = 0.f;
#pragma unroll
        for (int e = 0; e < 16; ++e) s += t[r][e] * t[r][e];
        const float rstd = 1.0f / sqrtf(wave_sum(s) * (1.f / DM) + EPS);
        float s2 = 0.f;
#pragma unroll
        for (int e = 0; e < 16; ++e) { x[r][e] += t[r][e] * rstd * gp[e]; s2 += x[r][e] * x[r][e]; }
        if (io[r].xnew) {
#pragma unroll
            for (int jj = 0; jj < 2; ++jj) { const int c0 = jj * 512 + 8 * lane;
                __builtin_nontemporal_store((f32x4){x[r][8 * jj], x[r][8 * jj + 1], x[r][8 * jj + 2], x[r][8 * jj + 3]}, (GAS f32x4*)(io[r].xnew + c0));
                __builtin_nontemporal_store((f32x4){x[r][8 * jj + 4], x[r][8 * jj + 5], x[r][8 * jj + 6], x[r][8 * jj + 7]}, (GAS f32x4*)(io[r].xnew + c0 + 4)); } }
        if (io[r].xb) {
            const float r2 = 1.0f / sqrtf(wave_sum(s2) * (1.f / DM) + EPS);
            if (lane == 0) *io[r].rs = r2;
#pragma unroll
            for (int jj = 0; jj < 2; ++jj) { const int c0 = jj * 512 + 8 * lane;
                v4u o; o.x = pk2(x[r][8 * jj] * r2, x[r][8 * jj + 1] * r2); o.y = pk2(x[r][8 * jj + 2] * r2, x[r][8 * jj + 3] * r2); o.z = pk2(x[r][8 * jj + 4] * r2, x[r][8 * jj + 5] * r2); o.w = pk2(x[r][8 * jj + 6] * r2, x[r][8 * jj + 7] * r2);
                *(GAS v4u*)(io[r].xb + c0) = o; }
        }
    }
}

constexpr int AT_KSLOT = 12288, AT_VSLOT = 8192, AT_VOFF = 3 * AT_KSLOT, AT_LDS = AT_VOFF + 3 * AT_VSLOT;
__device__ __forceinline__ void glds16(const void* gsrc, unsigned lds_dst) { unsigned keep;
    asm volatile("s_mov_b32 %0, m0\n\ts_mov_b32 m0, %2\n\ts_nop 0\n\tglobal_load_lds_dwordx4 %1, off\n\ts_mov_b32 m0, %0" : "=&s"(keep) : "v"(gsrc), "s"(lds_dst) : "memory"); }
__device__ __forceinline__ float xhalf_max(float v) { auto rr = __builtin_amdgcn_permlane32_swap(__float_as_uint(v), __float_as_uint(v), false, false); return __builtin_fmaxf(__uint_as_float(rr[0]), __uint_as_float(rr[1])); }
__device__ __forceinline__ float xhalf_sum(float v) { auto rr = __builtin_amdgcn_permlane32_swap(__float_as_uint(v), __float_as_uint(v), false, false); return __uint_as_float(rr[0]) + __uint_as_float(rr[1]); }
typedef __attribute__((address_space(3))) const char* lds_cptr;
__device__ __forceinline__ void at_kload2(bf16x8* kf, lds_cptr kp, int j) { kf[2 * j] = *(const LAS bf16x8*)(kp + j * 2048); kf[2 * j + 1] = *(const LAS bf16x8*)(kp + j * 2048 + 512); }
__device__ __forceinline__ unsigned at_cvtpk(float lo, float hi) { typedef float f2 __attribute__((ext_vector_type(2))); typedef __bf16 b2 __attribute__((ext_vector_type(2))); f2 v = {lo, hi}; b2 b = __builtin_convertvector(v, b2); return __builtin_bit_cast(unsigned, b); }
#define AT_SBAR() __builtin_amdgcn_sched_barrier(0)
#define AT_WAIT_BAR(N) asm volatile("s_waitcnt vmcnt(" #N ") lgkmcnt(0)\n\ts_barrier" ::: "memory")
__device__ __forceinline__ void attn_unit(const Ptrs& P, int b, int h, int qb, LAS char* lds, int tid) {
    asm volatile("" : "+v"(tid));
    const int lane = tid & 63, wid = __builtin_amdgcn_readfirstlane(tid >> 6), r32 = lane & 31, hi = lane >> 5;
    const bf16* Qn = (const bf16*)(P.ws + WS_QN); const bf16* Qr = (const bf16*)(P.ws + WS_QR); const bf16* KV = (const bf16*)(P.ws + WS_KV); const bf16* Z = (const bf16*)(P.ws + WS_Z);
    bf16* AG = (bf16*)(P.ws + WS_AG);
    const size_t rowbase = (size_t)b * SEQ; const int q0 = qb * 256, qrel = wid * 32 + r32, qrow = q0 + qrel;
    const unsigned lds0 = (unsigned)(uintptr_t)lds;
    const bf16* ksrc1 = KV + (rowbase + lane) * 1024 + h * 64 + wid * 8;
    const bf16* ksrc2 = Z + (rowbase + lane) * ZW + 384 + (wid & 3) * 8;
    const bf16* vsrc = KV + (rowbase + 16 * (wid & 3) + (lane >> 2)) * 1024 + 512 + h * 64 + (wid >> 2) * 32 + (lane & 3) * 8;
    const unsigned kd1 = lds0 + wid * 1024, kd2 = lds0 + (8 + (wid & 3)) * 1024, vd = lds0 + AT_VOFF + wid * 1024;
#define DMA_K(t, slot) do { glds16(ksrc1 + (size_t)(t) * 64 * 1024, (unsigned)__builtin_amdgcn_readfirstlane(kd1 + (slot) * AT_KSLOT)); glds16(ksrc2 + (size_t)(t) * 64 * ZW, (unsigned)__builtin_amdgcn_readfirstlane(kd2 + (slot) * AT_KSLOT)); } while (0)
#define DMA_V(t, slot) glds16(vsrc + (size_t)(t) * 64 * 1024, (unsigned)__builtin_amdgcn_readfirstlane(vd + (slot) * AT_VSLOT))
    const lds_cptr kp0 = (lds_cptr)lds + hi * 1024 + r32 * 16;
    const lds_cptr vp0 = (lds_cptr)lds + AT_VOFF + ((lane >> 4) & 1) * 32 + (lane & 3) * 8 + (4 * hi + ((lane & 15) >> 2)) * 64;
    const int NT = (q0 + 256) / 64;
    bf16x8 qr[6];
#pragma unroll
    for (int s = 0; s < 4; ++s) qr[s] = *(const GAS bf16x8*)(Qn + (rowbase + qrow) * 512 + h * 64 + 16 * s + 8 * hi);
#pragma unroll
    for (int s = 0; s < 2; ++s) qr[4 + s] = *(const GAS bf16x8*)(Qr + (rowbase + qrow) * 256 + h * 32 + 16 * s + 8 * hi);
    asm volatile("s_waitcnt vmcnt(0)" : "+v"(qr[0]), "+v"(qr[1]), "+v"(qr[2]), "+v"(qr[3]), "+v"(qr[4]), "+v"(qr[5]) :: "memory");
    DMA_K(0, 0); DMA_V(0, 0); DMA_K(1, 1); DMA_K(2, 2);
    float mhat = 0.f, l_reg = 0.f; f32x16 o0 = {}, o1 = {};
    bf16x8 kf[12];
#define CMASK(C0, C1, tt) do { const int jb_ = (tt) - (NT - 4); if (jb_ >= 0) { const int kb_ = 64 * jb_ + 4 * hi; \
        _Pragma("unroll") for (int r = 0; r < 16; ++r) { const int kv = kb_ + (r & 3) + 8 * (r >> 2); if (kv > qrel) C0[r] = -INFINITY; if (kv + 32 > qrel) C1[r] = -INFINITY; } } } while (0)
#define ROWMAX(C0, C1, out) do { float a_ = __builtin_fmaxf(__builtin_fmaxf(C0[0], C0[1]), C1[0]), b_ = __builtin_fmaxf(__builtin_fmaxf(C0[2], C0[3]), C1[1]); a_ = __builtin_fmaxf(__builtin_fmaxf(a_, C1[2]), C1[3]); \
        _Pragma("unroll") for (int r = 4; r < 16; r += 4) { a_ = __builtin_fmaxf(__builtin_fmaxf(a_, C0[r]), C0[r + 1]); b_ = __builtin_fmaxf(__builtin_fmaxf(b_, C0[r + 2]), C0[r + 3]); \
            a_ = __builtin_fmaxf(__builtin_fmaxf(a_, C1[r]), C1[r + 1]); b_ = __builtin_fmaxf(__builtin_fmaxf(b_, C1[r + 2]), C1[r + 3]); } \
        out = xhalf_max(__builtin_fmaxf(a_, b_)); } while (0)
    f32x16 pA0, pA1, pB0, pB1;
    AT_WAIT_BAR(5);
    {
#pragma unroll
        for (int j = 0; j < 6; ++j) at_kload2(kf, kp0, j);
        pA0 = __builtin_amdgcn_mfma_f32_32x32x16_bf16(kf[0], qr[0], (f32x16){}, 0, 0, 0); pA1 = __builtin_amdgcn_mfma_f32_32x32x16_bf16(kf[1], qr[0], (f32x16){}, 0, 0, 0);
#pragma unroll
        for (int s = 1; s < 6; ++s) { pA0 = __builtin_amdgcn_mfma_f32_32x32x16_bf16(kf[2 * s], qr[s], pA0, 0, 0, 0); pA1 = __builtin_amdgcn_mfma_f32_32x32x16_bf16(kf[2 * s + 1], qr[s], pA1, 0, 0, 0); }
        CMASK(pA0, pA1, 0);
        float rm; ROWMAX(pA0, pA1, rm); mhat = rm;
#pragma unroll
        for (int r = 0; r < 16; ++r) { pA0[r] = __builtin_amdgcn_exp2f(pA0[r] - mhat); pA1[r] = __builtin_amdgcn_exp2f(pA1[r] - mhat); }
    }
    AT_WAIT_BAR(0);
    DMA_K(3, 0); DMA_V(1, 1);
#pragma unroll
    for (int j = 0; j < 6; ++j) at_kload2(kf, kp0 + AT_KSLOT, j);
    AT_WAIT_BAR(3);
    s16x4 vlo[8], vhi[8]; v4u pw0, pw1, pw2, pw3;
    bool resc = false; float fsc = 1.f;
#define PKW(Pt, B) at_cvtpk(Pt[B], Pt[B + 1])
#define PAF(k) __builtin_bit_cast(bf16x8, pw##k)
#define VFR(i) cat8(vlo[i], vhi[i])
#define PIN(x) asm volatile("" : "+v"(x))
#define VRD(i) do { vlo[i] = vtr(vp_ + (((i) >> 2) * 4096 + ((i) & 3) * 1024)); vhi[i] = vtr(vp_ + (((i) >> 2) * 4096 + ((i) & 3) * 1024 + 512)); } while (0)
#define GAPA(MF, A0, A1, A2, A3, W0, W1, PW) do { MF; sacc += A0; sacc += A1; sacc += A2; sacc += A3; PIN(sacc); W0; W1; PIN(PW); AT_SBAR(); } while (0)
#define EXM(v) __builtin_amdgcn_exp2f((v) - mhat)
#define GAPB(MF, X, B) do { MF; X[B] = EXM(X[B]); X[B + 1] = EXM(X[B + 1]); X[B + 2] = EXM(X[B + 2]); X[B + 3] = EXM(X[B + 3]); PIN(X); AT_SBAR(); } while (0)
#define KRD(G, j) do { if (G) { at_kload2(kf, kp0 + sl_next * AT_KSLOT, j); AT_SBAR(); } } while (0)
#define STEP(C0, C1, P0, P1, t, GK, GV, GL) do { AT_SBAR(); \
        const lds_cptr vp_ = vp0 + sl_prev * AT_VSLOT; \
        VRD(0); AT_SBAR(); float sacc = (P0[0] + P0[1]); \
        GAPA(C0 = __builtin_amdgcn_mfma_f32_32x32x16_bf16(kf[0], qr[0], (f32x16){}, 0, 0, 0), P0[2], P0[3], P0[4], P0[5],     pw0[0] = PKW(P0, 0), pw0[1] = PKW(P0, 2), pw0); \
        VRD(4); AT_SBAR(); GAPA(C1 = __builtin_amdgcn_mfma_f32_32x32x16_bf16(kf[1], qr[0], (f32x16){}, 0, 0, 0), P0[6], P0[7], P0[8], P0[9],     pw0[2] = PKW(P0, 4), pw0[3] = PKW(P0, 6), pw0); \
        VRD(1); AT_SBAR(); GAPA(C0 = __builtin_amdgcn_mfma_f32_32x32x16_bf16(kf[2], qr[1], C0, 0, 0, 0),   P0[10], P0[11], P0[12], P0[13], pw1[0] = PKW(P0, 8), pw1[1] = PKW(P0, 10), pw1); \
        VRD(5); AT_SBAR(); GAPA(C1 = __builtin_amdgcn_mfma_f32_32x32x16_bf16(kf[3], qr[1], C1, 0, 0, 0),   P0[14], P0[15], P1[0], P1[1],   pw1[2] = PKW(P0, 12), pw1[3] = PKW(P0, 14), pw1); \
        VRD(2); AT_SBAR(); GAPA(C0 = __builtin_amdgcn_mfma_f32_32x32x16_bf16(kf[4], qr[2], C0, 0, 0, 0),   P1[2], P1[3], P1[4], P1[5],     pw2[0] = PKW(P1, 0), pw2[1] = PKW(P1, 2), pw2); \
        VRD(6); AT_SBAR(); GAPA(C1 = __builtin_amdgcn_mfma_f32_32x32x16_bf16(kf[5], qr[2], C1, 0, 0, 0),   P1[6], P1[7], P1[8], P1[9],     pw2[2] = PKW(P1, 4), pw2[3] = PKW(P1, 6), pw2); \
        VRD(3); AT_SBAR(); GAPA(C0 = __builtin_amdgcn_mfma_f32_32x32x16_bf16(kf[6], qr[3], C0, 0, 0, 0),   P1[10], P1[11], P1[12], P1[13], pw3[0] = PKW(P1, 8), pw3[1] = PKW(P1, 10), pw3); \
        VRD(7); AT_SBAR(); GAPA(C1 = __builtin_amdgcn_mfma_f32_32x32x16_bf16(kf[7], qr[3], C1, 0, 0, 0),   P1[14], P1[15], 0.f, 0.f,       pw3[2] = PKW(P1, 12), pw3[3] = PKW(P1, 14), pw3); \
        C0 = __builtin_amdgcn_mfma_f32_32x32x16_bf16(kf[8], qr[4], C0, 0, 0, 0); C1 = __builtin_amdgcn_mfma_f32_32x32x16_bf16(kf[9], qr[4], C1, 0, 0, 0); \
        C0 = __builtin_amdgcn_mfma_f32_32x32x16_bf16(kf[10], qr[5], C0, 0, 0, 0); C1 = __builtin_amdgcn_mfma_f32_32x32x16_bf16(kf[11], qr[5], C1, 0, 0, 0); \
        l_reg += sacc; \
        if (GK) { DMA_K((t) + 3, sl_cur); } if (GV) { DMA_V((t) + 1, sl_next); } \
        CMASK(C0, C1, t); \
        { float rm; ROWMAX(C0, C1, rm); resc = false; \
          if (__builtin_expect(__any(rm - mhat > 8.0f), 0)) { const float nm = __builtin_fmaxf(rm, mhat); fsc = __builtin_amdgcn_exp2f(mhat - nm); mhat = nm; l_reg *= fsc; resc = true; } } \
        AT_SBAR(); \
        GAPB(o0 = __builtin_amdgcn_mfma_f32_32x32x16_bf16(VFR(0), PAF(0), o0, 0, 0, 0), C0, 0); \
        GAPB(o1 = __builtin_amdgcn_mfma_f32_32x32x16_bf16(VFR(4), PAF(0), o1, 0, 0, 0), C0, 4); \
        KRD(GL, 0); GAPB(o0 = __builtin_amdgcn_mfma_f32_32x32x16_bf16(VFR(1), PAF(1), o0, 0, 0, 0), C0, 8); \
        KRD(GL, 1); GAPB(o1 = __builtin_amdgcn_mfma_f32_32x32x16_bf16(VFR(5), PAF(1), o1, 0, 0, 0), C0, 12); \
        KRD(GL, 2); GAPB(o0 = __builtin_amdgcn_mfma_f32_32x32x16_bf16(VFR(2), PAF(2), o0, 0, 0, 0), C1, 0); \
        KRD(GL, 3); GAPB(o1 = __builtin_amdgcn_mfma_f32_32x32x16_bf16(VFR(6), PAF(2), o1, 0, 0, 0), C1, 4); \
        KRD(GL, 4); GAPB(o0 = __builtin_amdgcn_mfma_f32_32x32x16_bf16(VFR(3), PAF(3), o0, 0, 0, 0), C1, 8); \
        KRD(GL, 5); GAPB(o1 = __builtin_amdgcn_mfma_f32_32x32x16_bf16(VFR(7), PAF(3), o1, 0, 0, 0), C1, 12); \
    } while (0)
#define RESC() do { if (resc) { _Pragma("unroll") for (int r = 0; r < 16; ++r) { o0[r] *= fsc; o1[r] *= fsc; } } } while (0)
    int sl_prev = 0, sl_cur = 1, sl_next = 2;
#define ROT() do { sl_prev = sl_cur; sl_cur = sl_next; sl_next = (sl_next == 2) ? 0 : sl_next + 1; } while (0)
#define ENDW(tt) do { if ((tt) + 3 < NT) { AT_WAIT_BAR(3); } else if ((tt) + 2 < NT) { AT_WAIT_BAR(1); } else { AT_WAIT_BAR(0); } } while (0)
    int t = 1;
    for (; t + 1 < NT; t += 2) {
        STEP(pB0, pB1, pA0, pA1, t, (t + 3 < NT), (t + 1 < NT), (t + 1 < NT));         ENDW(t);     RESC(); ROT();
        STEP(pA0, pA1, pB0, pB1, t + 1, (t + 4 < NT), (t + 2 < NT), (t + 2 < NT));     ENDW(t + 1); RESC(); ROT();
    }
    STEP(pB0, pB1, pA0, pA1, NT - 1, false, false, false); RESC();
    { float sacc = 0.f;
#pragma unroll
      for (int r = 0; r < 16; ++r) sacc += pB0[r] + pB1[r];
      l_reg += sacc;
      const lds_cptr vp_ = vp0 + sl_cur * AT_VSLOT;
#pragma unroll
      for (int ks = 0; ks < 4; ++ks) { const f32x16& pp = (ks >> 1) ? pB1 : pB0; const int s2 = ks & 1;
          const bf16x8 pf = pack8(pp[8 * s2], pp[8 * s2 + 1], pp[8 * s2 + 2], pp[8 * s2 + 3], pp[8 * s2 + 4], pp[8 * s2 + 5], pp[8 * s2 + 6], pp[8 * s2 + 7]);
          const lds_cptr vb = vp_ + ks * 1024;
          const bf16x8 v0 = cat8(vtr(vb), vtr(vb + 512)), v1 = cat8(vtr(vb + 4096), vtr(vb + 4096 + 512));
          o0 = __builtin_amdgcn_mfma_f32_32x32x16_bf16(v0, pf, o0, 0, 0, 0); o1 = __builtin_amdgcn_mfma_f32_32x32x16_bf16(v1, pf, o1, 0, 0, 0); } }
#undef DMA_K
#undef DMA_V
#undef CMASK
#undef ROWMAX
#undef PKW
#undef PAF
#undef VFR
#undef PIN
#undef VRD
#undef GAPA
#undef EXM
#undef GAPB
#undef KRD
#undef STEP
#undef RESC
#undef ROT
#undef ENDW
    l_reg = xhalf_sum(l_reg);
    const float rl = 1.0f / l_reg;
    bf16* orow = AG + (rowbase + qrow) * 1024 + h * 64;
#pragma unroll
    for (int q = 0; q < 4; ++q) { v2u w; w.x = pk2(o0[4 * q] * rl, o0[4 * q + 1] * rl); w.y = pk2(o0[4 * q + 2] * rl, o0[4 * q + 3] * rl); *(GAS v2u*)(orow + 8 * q + 4 * hi) = w;
        v2u w1; w1.x = pk2(o1[4 * q] * rl, o1[4 * q + 1] * rl); w1.y = pk2(o1[4 * q + 2] * rl, o1[4 * q + 3] * rl); *(GAS v2u*)(orow + 32 + 8 * q + 4 * hi) = w1; }
    asm volatile("s_waitcnt lgkmcnt(0)\n\ts_barrier" ::: "memory");
}

constexpr int MG_SLOT = 24576, MG_BOFF = 16384;
template <class Epi>
__device__ __forceinline__ void mid_gemm(const bf16* A, int lda, const bf16* Bt, int ldb, int Kper, int ntn, int KS, const Epi& E, int bx, int G, LAS char* lds, int tid) {
    asm volatile("" : "+v"(tid));
    const int lane = tid & 63, wid = __builtin_amdgcn_readfirstlane(tid >> 6), r32 = lane & 31, hi = lane >> 5, mb = wid & 3, nb = wid >> 2;
    const unsigned lds0 = (unsigned)(uintptr_t)lds;
    const int nitem = 4 * ntn * KS, nk = Kper / 64;
    for (int item = bx; item < nitem; item += G) {
        const int tm = item & 3, rest = item >> 2, tn = rest % ntn, ks = rest / ntn;
        const bf16* a0 = A + (size_t)(tm * 128 + (wid & 1) * 64 + lane) * lda + ks * Kper + (wid >> 1) * 8;
        const bf16* a1 = a0 + 32;
        const bf16* b0 = Bt + (size_t)(tn * 64 + lane) * ldb + ks * Kper + wid * 8;
        const unsigned da0 = lds0 + (wid >> 1) * 2048 + (wid & 1) * 1024, da1 = da0 + 4 * 2048, db0 = lds0 + MG_BOFF + wid * 1024;
#define MG_ISSUE(t, so) do { glds16(a0 + (t) * 64, (unsigned)__builtin_amdgcn_readfirstlane(da0 + (so))); glds16(a1 + (t) * 64, (unsigned)__builtin_amdgcn_readfirstlane(da1 + (so))); \
                             glds16(b0 + (t) * 64, (unsigned)__builtin_amdgcn_readfirstlane(db0 + (so))); } while (0)
        __syncthreads();
        MG_ISSUE(0, 0); if (nk > 1) MG_ISSUE(1, MG_SLOT);
        f32x16 acc = {}, acc2 = {};
        const LAS char* ap = lds + hi * 2048 + (mb * 32 + r32) * 16;
        const LAS char* bp = lds + MG_BOFF + hi * 1024 + (nb * 32 + r32) * 16;
        int sc = 0, s2 = 2 * MG_SLOT;
        for (int t = 0; t < nk; ++t) {
            if (t + 1 < nk) asm volatile("s_waitcnt vmcnt(3)\n\ts_barrier" ::: "memory"); else asm volatile("s_waitcnt vmcnt(0)\n\ts_barrier" ::: "memory");
            if (t + 2 < nk) MG_ISSUE(t + 2, s2);
#pragma unroll
            for (int s = 0; s < 4; ++s) { const bf16x8 af = *(const LAS bf16x8*)(ap + sc + s * 4096), bfr = *(const LAS bf16x8*)(bp + sc + s * 2048);
                if (s & 1) acc2 = __builtin_amdgcn_mfma_f32_32x32x16_bf16(bfr, af, acc2, 0, 0, 0); else acc = __builtin_amdgcn_mfma_f32_32x32x16_bf16(bfr, af, acc, 0, 0, 0); }
            sc = (sc == 2 * MG_SLOT) ? 0 : sc + MG_SLOT; s2 = (s2 == 2 * MG_SLOT) ? 0 : s2 + MG_SLOT;
        }
#undef MG_ISSUE
        acc += acc2;
        E(acc, tm * 128 + mb * 32 + r32, tn * 64 + nb * 32, ks, hi);
        asm volatile("s_waitcnt lgkmcnt(0)\n\ts_barrier" ::: "memory");
    }
}

constexpr int G_PITCH = 528;
__device__ __forceinline__ void gate_unit(const Ptrs& P, int l, int chunk, LAS char* lds, int tid) {
    asm volatile("" : "+v"(tid));
    const int lane = tid & 63, wid = __builtin_amdgcn_readfirstlane(tid >> 6), r32 = lane & 31, hi = lane >> 5;
    const bf16* Z = (const bf16*)(P.ws + WS_Z); bf16* AG = (bf16*)(P.ws + WS_AG);
    const bf16* Wsp = (const bf16*)(P.ws + WS_WL + (size_t)l * WL_STRIDE + WL_WSP);
    const size_t row0 = (size_t)chunk * CHUNK;
    const int iblk = wid >> 1, dblk = wid & 1, nsteps = 2 * (iblk + 1);
    const size_t irow = row0 + iblk * 32 + r32;
    for (int pass = 0; pass < 2; ++pass) {
        __syncthreads();
#pragma unroll
        for (int i = 0; i < 8; ++i) { const int c = tid + 512 * i, j = c >> 5, ch = c & 31; const v4u vv = *(const GAS v4u*)(Z + (row0 + j) * ZW + 1024 + pass * 256 + ch * 8);
            const float* sp = (const float*)(P.ws + WS_SSV) + (row0 + j) * 8; const f32x4 s0 = *(const GAS f32x4*)sp, s1 = *(const GAS f32x4*)(sp + 4);
            const float rv = 1.0f / sqrtf((((s0.x + s0.y) + (s0.z + s0.w)) + ((s1.x + s1.y) + (s1.z + s1.w))) * (1.f / GMW) + EPS);
            const float* gp = P.v_norm + l * GMW + pass * 256 + ch * 8; const f32x4 g0 = *(const f32x4*)gp, g1 = *(const f32x4*)(gp + 4);
            v4u o; o.x = pk2(bflo(vv.x) * rv * g0.x, bfhi(vv.x) * rv * g0.y); o.y = pk2(bflo(vv.y) * rv * g0.z, bfhi(vv.y) * rv * g0.w);
            o.z = pk2(bflo(vv.z) * rv * g1.x, bfhi(vv.z) * rv * g1.y); o.w = pk2(bflo(vv.w) * rv * g1.z, bfhi(vv.w) * rv * g1.w);
            *(LAS v4u*)(lds + j * G_PITCH + ch * 16) = o; }
        __syncthreads();
        bf16x8 a[8], an[8]; v2u uu[4], un[4]; float bsv, bsn;
#define G_LOAD(A_, U_, B_, g_) do { _Pragma("unroll") for (int s = 0; s < 8; ++s) A_[s] = *(const GAS bf16x8*)(Wsp + ((size_t)(g_) * 128 + iblk * 32 + r32) * 128 + 16 * s + 8 * hi); \
            B_ = P.b_sp[((size_t)l * 8 + (g_)) * 128 + iblk * 32 + r32]; \
            _Pragma("unroll") for (int q = 0; q < 4; ++q) U_[q] = *(const GAS v2u*)(Z + irow * ZW + 512 + (g_) * 64 + dblk * 32 + 8 * q + 4 * hi); } while (0)
        G_LOAD(a, uu, bsv, pass * 4);
#pragma unroll
        for (int gg = 0; gg < 4; ++gg) {
            const int g = pass * 4 + gg;
            if (gg < 3) G_LOAD(an, un, bsn, g + 1);
            f32x16 acc = {};
            const LAS char* vb0 = lds + (8 * hi + ((lane & 15) >> 2)) * G_PITCH + (gg * 64 + dblk * 32 + 16 * ((lane >> 4) & 1) + 4 * (lane & 3)) * 2;
#pragma unroll
            for (int s = 0; s < 8; ++s) if (s < nsteps) {
                const LAS char* vb = vb0 + 16 * s * G_PITCH;
                const bf16x8 bb = cat8(vtr(vb), vtr(vb + 4 * G_PITCH));
                acc = __builtin_amdgcn_mfma_f32_32x32x16_bf16(bb, a[s], acc, 0, 0, 0);
            }
            bf16* op = AG + irow * 1024 + 512 + g * 64 + dblk * 32 + 4 * hi;
#pragma unroll
            for (int q = 0; q < 4; ++q) { const float u0 = bflo(uu[q].x), u1 = bfhi(uu[q].x), u2 = bflo(uu[q].y), u3 = bfhi(uu[q].y);
                v2u w; w.x = pk2(u0 * (acc[4 * q] + bsv), u1 * (acc[4 * q + 1] + bsv)); w.y = pk2(u2 * (acc[4 * q + 2] + bsv), u3 * (acc[4 * q + 3] + bsv));
                *(GAS v2u*)(op + 8 * q) = w; }
            if (gg < 3) {
#pragma unroll
                for (int s = 0; s < 8; ++s) a[s] = an[s];
#pragma unroll
                for (int q = 0; q < 4; ++q) uu[q] = un[q];
                bsv = bsn; }
        }
#undef G_LOAD
    }
    __syncthreads();
}

constexpr int SV_PITCH = 336, SV_WAVE = 32 * SV_PITCH, SQ_BYTES = 10240;
#define SGLD(dst, ptr, off) asm volatile("global_load_dwordx4 %0, %1, off offset:" #off " nt" : "=&v"(dst) : "v"(ptr) : "memory")
__device__ __forceinline__ void sample_unit(const Ptrs& P, int l, int b, LAS char* lds, int tid) {
    asm volatile("" : "+v"(tid));
    const int lane = tid & 63, wid = __builtin_amdgcn_readfirstlane(tid >> 6), r32 = lane & 31, hi = lane >> 5;
    const bf16* Qs = (const bf16*)(P.ws + WS_QS); const bf16* Z = (const bf16*)(P.ws + WS_Z); bf16* AG = (bf16*)(P.ws + WS_AG);
    __syncthreads();
    for (int idx = tid; idx < 640; idx += 512) { const int s = idx >> 6, ln = idx & 63, q = ln & 31, h8 = ln >> 5; const int qt = q >> 3, qh = q & 7;
        const bf16* src = Qs + ((size_t)b * 4 + qt) * 1280 + (s < 8 ? qh * 128 + 16 * s : 1024 + qh * 32 + 16 * (s - 8)) + 8 * h8;
        *(LAS v4u*)(lds + idx * 16) = *(const GAS v4u*)src; }
    const int qt = r32 >> 3;
    f32x16 o[4];
#pragma unroll
    for (int cb = 0; cb < 4; ++cb) o[cb] = (f32x16){};
    float mrun = -1e30f, lrun = 0.f;
    LAS char* vimg = lds + SQ_BYTES + wid * SV_WAVE;
    const float* cc = P.cache_c + (size_t)l * NPHYS * PAGE * KVL; const float* cr = P.cache_r + (size_t)l * NPHYS * PAGE * ROPE;
    const int pgv = P.ptab[b * NPAGES + lane];
    __syncthreads();
    const int ntile = 32 + (wid == 0 ? 1 : 0);
    f32x4 raw[20];
#define S_ISSUE(it_) do { const int it__ = (it_); \
        if (it__ < 32) { const int ph0 = __shfl(pgv, 2 * it__), ph1 = __shfl(pgv, 2 * it__ + 1); \
            const float* kc0 = cc + ((size_t)ph0 * PAGE + 16 * wid + (lane >> 5)) * KVL + (lane & 31) * 4; const float* kc1 = cc + ((size_t)ph1 * PAGE + 16 * wid + (lane >> 5)) * KVL + (lane & 31) * 4; \
            const float* kr0 = cr + ((size_t)ph0 * PAGE + 16 * wid + (lane >> 3)) * ROPE + (lane & 7) * 4; const float* kr1 = cr + ((size_t)ph1 * PAGE + 16 * wid + (lane >> 3)) * ROPE + (lane & 7) * 4; \
            _Pragma("unroll") for (int j = 0; j < 8; ++j) { const float* pp = kc0 + (size_t)(2 * j) * KVL; SGLD(raw[j], pp, 0); } \
            _Pragma("unroll") for (int j = 0; j < 8; ++j) { const float* pp = kc1 + (size_t)(2 * j) * KVL; SGLD(raw[8 + j], pp, 0); } \
            _Pragma("unroll") for (int j = 0; j < 2; ++j) { const float* pp = kr0 + (size_t)(8 * j) * ROPE; SGLD(raw[16 + j], pp, 0); } \
            _Pragma("unroll") for (int j = 0; j < 2; ++j) { const float* pp = kr1 + (size_t)(8 * j) * ROPE; SGLD(raw[18 + j], pp, 0); } \
        } else { const float* kc = P.out + O_CKV_S + ((size_t)l * MS + b * 4) * KVL + (lane & 31) * 4; const float* kr = P.out + O_KR_S + ((size_t)l * MS + b * 4) * ROPE + (lane & 7) * 4; \
            _Pragma("unroll") for (int j = 0; j < 16; ++j) { const float* pp = kc + (size_t)((2 * j + (lane >> 5)) & 3) * KVL; SGLD(raw[j], pp, 0); } \
            _Pragma("unroll") for (int j = 0; j < 4; ++j) { const float* pp = kr + (size_t)((8 * j + (lane >> 3)) & 3) * ROPE; SGLD(raw[16 + j], pp, 0); } } } while (0)
    S_ISSUE(0);
    for (int it = 0; it < ntile; ++it) {
        asm volatile("s_waitcnt vmcnt(0)" : "+v"(raw[0]), "+v"(raw[1]), "+v"(raw[2]), "+v"(raw[3]), "+v"(raw[4]), "+v"(raw[5]), "+v"(raw[6]), "+v"(raw[7]), "+v"(raw[8]), "+v"(raw[9]),
                     "+v"(raw[10]), "+v"(raw[11]), "+v"(raw[12]), "+v"(raw[13]), "+v"(raw[14]), "+v"(raw[15]), "+v"(raw[16]), "+v"(raw[17]), "+v"(raw[18]), "+v"(raw[19]) :: "memory");
#pragma unroll
        for (int j = 0; j < 16; ++j) { v2u w; w.x = pg8::cvt_pk_bf16(raw[j].x, raw[j].y); w.y = pg8::cvt_pk_bf16(raw[j].z, raw[j].w); *(LAS v2u*)(vimg + (2 * j + (lane >> 5)) * SV_PITCH + (lane & 31) * 8) = w; }
#pragma unroll
        for (int j = 0; j < 4; ++j) { v2u w; w.x = pg8::cvt_pk_bf16(raw[16 + j].x, raw[16 + j].y); w.y = pg8::cvt_pk_bf16(raw[16 + j].z, raw[16 + j].w); *(LAS v2u*)(vimg + (8 * j + (lane >> 3)) * SV_PITCH + 256 + (lane & 7) * 8) = w; }
        const bool newt = it >= 32;
        if (it + 1 < ntile) S_ISSUE(it + 1);
        LDS_WAIT();
        f32x16 p = {};
#pragma unroll 2
        for (int s = 0; s < 10; ++s) { const bf16x8 kf = *(const LAS bf16x8*)(vimg + r32 * SV_PITCH + (16 * s + 8 * hi) * 2), qf = *(const LAS bf16x8*)(lds + (s * 64 + lane) * 16);
            p = __builtin_amdgcn_mfma_f32_32x32x16_bf16(kf, qf, p, 0, 0, 0); }
        if (newt) {
#pragma unroll
            for (int r = 0; r < 16; ++r) { const int key = crow(r, hi); if (key > qt) p[r] = -INFINITY; }
        }
        float mx = p[0];
#pragma unroll
        for (int r = 1; r < 16; ++r) mx = fmaxf(mx, p[r]);
        mx = fmaxf(mx, __shfl_xor(mx, 32));
        const float mnew = fmaxf(mrun, mx), alpha = __builtin_amdgcn_exp2f(mrun - mnew); mrun = mnew;
        float ps = 0.f;
#pragma unroll
        for (int r = 0; r < 16; ++r) { p[r] = __builtin_amdgcn_exp2f(p[r] - mnew); ps += p[r]; }
        lrun = lrun * alpha + ps;
#pragma unroll
        for (int cb = 0; cb < 4; ++cb)
#pragma unroll
            for (int r = 0; r < 16; ++r) o[cb][r] *= alpha;
        LDS_WAIT();
#pragma unroll
        for (int s2 = 0; s2 < 2; ++s2) {
            const bf16x8 pf = pack8(p[8 * s2], p[8 * s2 + 1], p[8 * s2 + 2], p[8 * s2 + 3], p[8 * s2 + 4], p[8 * s2 + 5], p[8 * s2 + 6], p[8 * s2 + 7]);
            const LAS char* vb = vimg + (16 * s2 + 4 * hi + ((lane & 15) >> 2)) * SV_PITCH + (16 * ((lane >> 4) & 1) + 4 * (lane & 3)) * 2;
#pragma unroll
            for (int cb = 0; cb < 4; ++cb) { const bf16x8 vf = cat8(vtr(vb + cb * 64), vtr(vb + cb * 64 + 8 * SV_PITCH)); o[cb] = __builtin_amdgcn_mfma_f32_32x32x16_bf16(vf, pf, o[cb], 0, 0, 0); }
        }
        LDS_WAIT();
    }
#undef S_ISSUE
    lrun += __shfl_xor(lrun, 32);
    __syncthreads();
    LAS float* ost = (LAS float*)lds; LAS float* mst = (LAS float*)(lds + 132096); LAS float* lst = mst + 256;
#pragma unroll
    for (int cb = 0; cb < 4; ++cb)
#pragma unroll
        for (int r = 0; r < 16; ++r) ost[(wid * 128 + cb * 32 + crow(r, hi)) * 32 + r32] = o[cb][r];
    if (hi == 0) { mst[wid * 32 + r32] = mrun; lst[wid * 32 + r32] = lrun; }
    __syncthreads();
    {
        const int q = tid >> 4, c0 = (tid & 15) * 8;
        float mm = mst[q];
#pragma unroll
        for (int w = 1; w < 8; ++w) mm = fmaxf(mm, mst[w * 32 + q]);
        float sc[8], lt = 0.f;
#pragma unroll
        for (int w = 0; w < 8; ++w) { sc[w] = __builtin_amdgcn_exp2f(mst[w * 32 + q] - mm); lt += lst[w * 32 + q] * sc[w]; }
        const float rl = 1.0f / lt;
        float ol[8];
#pragma unroll
        for (int e = 0; e < 8; ++e) { float a = 0.f;
#pragma unroll
            for (int w = 0; w < 8; ++w) a += ost[(w * 128 + c0 + e) * 32 + q] * sc[w];
            ol[e] = a * rl; }
        __syncthreads();
        LAS float* olat = (LAS float*)lds;
#pragma unroll
        for (int e = 0; e < 8; ++e) olat[q * 128 + c0 + e] = ol[e];
    }
    __syncthreads();
    {
        const LAS float* olat = (const LAS float*)lds;
        const int q = tid >> 4, v0 = (tid & 15) * 4, h = q & 7, t = q >> 3;
        const float* wv = P.w_uv + (size_t)l * KVL * 512 + h * 64 + v0;
        f32x4 a = {0.f, 0.f, 0.f, 0.f};
#pragma unroll 32
        for (int c = 0; c < 128; ++c) { const f32x4 w = *(const GAS f32x4*)(wv + (size_t)c * 512); a += w * olat[q * 128 + c]; }
        v2u w; w.x = pk2(a.x, a.y); w.y = pk2(a.z, a.w);
        *(GAS v2u*)(AG + ((size_t)MP + b * 4 + t) * 1024 + h * 64 + v0) = w;
    }
    {
        const int col = tid, g = col >> 6;
        float vn[4], uu[4];
#pragma unroll
        for (int t = 0; t < 4; ++t) { vn[t] = bf2f(Z[((size_t)MP + b * 4 + t) * ZW + 1024 + col]); uu[t] = bf2f(Z[((size_t)MP + b * 4 + t) * ZW + 512 + col]); }
        const float* ws = P.w_sp + ((size_t)l * 8 + g) * 128 * 128; const float* bs = P.b_sp + ((size_t)l * 8 + g) * 128;
#pragma unroll
        for (int t = 0; t < 4; ++t) { float a = bs[t];
#pragma unroll
            for (int j = 0; j <= t; ++j) a += ws[t * 128 + j] * vn[j];
            AG[((size_t)MP + b * 4 + t) * 1024 + 512 + col] = (bf16)f2bf(uu[t] * a); }
    }
    __syncthreads();
}
constexpr int NWAVES = 8;
#ifndef NO_SAMPLE
#define NO_SAMPLE 0
#endif
#ifndef NO_ATTN
#define NO_ATTN 0
#endif
#ifndef NO_GATE
#define NO_GATE 0
#endif
#ifndef QPER
#define QPER 4
#endif
#ifndef PH_MASK
#define PH_MASK 0x3ff
#endif
#define PHEN(k) (((PH_MASK) >> (k)) & 1)
#ifndef PH_DOUBLE
#define PH_DOUBLE 0
#endif
#define PHREP(k) (1 + (((PH_DOUBLE) >> (k)) & 1))
constexpr int N_PHASES = 1 + 9 * DEPTH;
struct Args { Ptrs p; int ph_lo, ph_hi, one_launch, pad; };

__global__ void __launch_bounds__(NWAVES * 64, 2) fwd(Args args) {
    extern __shared__ __attribute__((aligned(16))) unsigned char lds_raw[];
    LAS unsigned char* lds = (LAS unsigned char*)lds_raw;
    const Ptrs& P = args.p;
    const int tid = threadIdx.x;
    const int G = gridDim.x; const int bx = blockIdx.x; const int vcu = (G % 8 == 0) ? (bx % 8) * (G / 8) + bx / 8 : bx;
    const int NGW = G * NWAVES;
    gu32* ctl = (gu32*)(P.ws + WS_CTL);
    for (int u = tid; u < (LDS_BYTES - LDSCTL_OFF) / 4; u += NWAVES * 64) ((LAS unsigned*)(lds + LDSCTL_OFF))[u] = 0u;
    __syncthreads();
    XcdBarrier bar; bar.bar = (unsigned*)(ctl + CW_BAR); bar.x = 0; bar.st = nullptr;
    if (args.one_launch) bar = xcd_barrier_post((unsigned*)(ctl + CW_BAR), (volatile LAS unsigned*)(lds + MISC_OFF) + 8);
    const int lo = args.ph_lo, hi_ = args.ph_hi;
#define IN(k) (lo <= (k) && (k) < hi_)
#define SEAM(k) do { if (IN(k) && IN((k) + 1)) { xcd_barrier(bar); for (int rb_ = 1; rb_ < PHREP(14); ++rb_) xcd_barrier(bar); } } while (0)

    bf16* Hb = (bf16*)(P.ws + WS_H); bf16* Zb = (bf16*)(P.ws + WS_Z); bf16* AGb = (bf16*)(P.ws + WS_AG); bf16* MIXb = (bf16*)(P.ws + WS_MIX); bf16* Rb = (bf16*)(P.ws + WS_R);
    float* FSb = (float*)(P.ws + WS_FS); float* RSb = (float*)(P.ws + WS_RS);
    const float* ropet = (const float*)(P.ws + WS_ROPE);

    for (int rep_ = 0; rep_ < PHREP(0); ++rep_) if (PHEN(0) && IN(0)) {
            int ptid = threadIdx.x; asm volatile("" : "+v"(ptid)); const int lane = ptid & 63, wave = __builtin_amdgcn_readfirstlane(ptid >> 6), gw = vcu * NWAVES + wave; (void)lane; (void)gw;
        LAS float* scr = (LAS float*)(lds + RING_OFF + wave * 16384);
        constexpr int I_IN = (DM / 64) * (INW / 32), I_UQ = (QL / 64) * (768 / 32), I_UK = (KVL / 64) * (512 / 32), I_OUT = (DM / 64) * (DM / 32), I_UP = (DM / 64) * (DFF / 32), I_DN = (DFF / 64) * (DM / 32);
        constexpr int I_PAD = 96, I_QA = 1024, I_SP = 256;
        constexpr int PER_L = I_IN + I_UQ + 2 * I_UK + I_OUT + I_UP + I_DN + I_PAD + I_QA + I_SP;
        for (int it0 = gw; it0 < DEPTH * PER_L; it0 += NGW) {
            const int l = it0 / PER_L; int r = it0 - l * PER_L;
            unsigned char* wl = P.ws + WS_WL + (size_t)l * WL_STRIDE;
            if (r < I_IN) { p0_transpose_item<1>(P.w_in + (size_t)l * DM * INW, DM, INW, (bf16*)(wl + WL_WIN), 0, scr, r, lane, P.nm_pre + l * DM); continue; } r -= I_IN;
            if (r < I_UQ) { p0_transpose_item<2>(P.w_uq + (size_t)l * QL * 768, QL, 768, (bf16*)(wl + WL_WUQ), 0, scr, r, lane, P.q_norm + l * QL); continue; } r -= I_UQ;
            if (r < I_UK) { p0_transpose_item<0>(P.w_uk + (size_t)l * KVL * 512, KVL, 512, (bf16*)(wl + WL_WKV), 0, scr, r, lane); continue; } r -= I_UK;
            if (r < I_UK) { p0_transpose_item<0>(P.w_uv + (size_t)l * KVL * 512, KVL, 512, (bf16*)(wl + WL_WKV), 512, scr, r, lane); continue; } r -= I_UK;
            if (r < I_OUT) { p0_transpose_item<0>(P.w_out + (size_t)l * DM * DM, DM, DM, (bf16*)(wl + WL_WOUT), 0, scr, r, lane); continue; } r -= I_OUT;
            if (r < I_UP) { p0_transpose_item<0>(P.w_up + (size_t)l * DM * DFF, DM, DFF, (bf16*)(wl + WL_WUP), 0, scr, r, lane, P.nf_pre + l * DM); continue; } r -= I_UP;
            if (r < I_DN) { p0_transpose_item<0>(P.w_dn + (size_t)l * DFF * DM, DFF, DM, (bf16*)(wl + WL_WDN), 0, scr, r, lane); continue; } r -= I_DN;
            if (r < I_PAD) {
                bf16* d = (bf16*)(wl + WL_WIN) + (size_t)(416 + r) * DM;
#pragma unroll
                for (int j = 0; j < 2; ++j) *(GAS v4u*)(d + j * 512 + 8 * lane) = (v4u){0u, 0u, 0u, 0u};
                continue; } r -= I_PAD;
            if (r < I_QA) {
                const int h = r >> 7, c = r & 127; const float* uq = P.w_uq + (size_t)l * QL * 768 + h * 96; const float* uk = P.w_uk + (size_t)l * KVL * 512 + (size_t)c * 512 + h * 64;
                bf16* d = (bf16*)(wl + WL_WQS) + (size_t)r * QL;
#pragma unroll 1
                for (int m = 0; m < 4; ++m) { const int k = lane + 64 * m; float a = 0.f;
#pragma unroll 4
                    for (int n = 0; n < 64; n += 4) { const f32x4 x = *(const GAS f32x4*)(uq + (size_t)k * 768 + n), y = *(const GAS f32x4*)(uk + n); a += (x.x * y.x + x.y * y.y) + (x.z * y.z + x.w * y.w); }
                    d[k] = (bf16)f2bf(a); }
                continue; } r -= I_QA;
            {
                const size_t e0 = (size_t)r * 512 + 8 * lane; const float* src = P.w_sp + (size_t)l * 8 * 128 * 128 + e0; bf16* d = (bf16*)(wl + WL_WSP) + e0;
                const int i = (int)((e0 >> 7) & 127), j0 = (int)(e0 & 127);
                const f32x4 a = *(const GAS f32x4*)src, b2 = *(const GAS f32x4*)(src + 4); const float v[8] = {a.x, a.y, a.z, a.w, b2.x, b2.y, b2.z, b2.w};
                float m[8];
#pragma unroll
                for (int e = 0; e < 8; ++e) m[e] = (j0 + e <= i) ? v[e] : 0.f;
                v4u o; o.x = pk2(m[0], m[1]); o.y = pk2(m[2], m[3]); o.z = pk2(m[4], m[5]); o.w = pk2(m[6], m[7]); *(GAS v4u*)d = o;
            }
        }
        for (int e = gw * 64 + lane; e < NPOS * 16; e += NGW * 64) { const int pi = e >> 4, i = e & 15; const int pos = pi < SEQ ? pi : PAST + (pi - SEQ); float c, s; rope_entry(pos, i, c, s);
            *(GAS f32x2*)((float*)(P.ws + WS_ROPE) + (size_t)e * 2) = (f32x2){c, s}; }
        for (int m0 = gw; m0 < M; m0 += 4 * NGW) { const float* xr[4]; bf16* orow[4]; float* rsp[4]; bool valid[4];
#pragma unroll
            for (int r = 0; r < 4; ++r) { const int m = m0 + r * NGW; valid[r] = m < M; const int mm = valid[r] ? m : m0;
                xr[r] = mm < MP ? P.x_p + (size_t)mm * DM : P.x_s + (size_t)(mm - MP) * DM; orow[r] = Hb + (size_t)mm * DM; rsp[r] = RSb + mm; }
            rows_to_bf16_rs<4>(xr, orow, rsp, valid, lane); }
    }
    SEAM(0);

    for (int l = 0; l < DEPTH; ++l) {
        const int pb = 1 + 9 * l;
        unsigned char* wl = P.ws + WS_WL + (size_t)l * WL_STRIDE;
        for (int rep_ = 0; rep_ < PHREP(1); ++rep_) if (PHEN(1) && IN(pb + 0)) {
            int ptid = threadIdx.x; asm volatile("" : "+v"(ptid)); const int lane = ptid & 63, wave = __builtin_amdgcn_readfirstlane(ptid >> 6), gw = vcu * NWAVES + wave; (void)lane; (void)gw;
            { SEpiBf16<0> E{Zb + (size_t)MP * ZW, ZW, nullptr}; for (int r3 = 0; r3 < PHREP(13); ++r3) mid_gemm(Hb + (size_t)MP * DM, DM, (const bf16*)(wl + WL_WIN), DM, DM, ZW / 64, 1, E, bx, G, (LAS char*)lds, ptid); }
            __syncthreads();
            pg8::Gemm g{Hb, (const bf16*)(wl + WL_WIN), DM, DM, DM}; pg8::StaticOrder S; S.init(MP / 256, ZW / 256, G, bx);
            pg8::EpiZ E{Zb, ZW, (float*)(P.ws + WS_SSQ), (float*)(P.ws + WS_SSV)};
            pg8::gemm_phase<pg8::EpiZ, pg8::StaticOrder, true, true>(lds + RING_OFF, g, S, E, ptid);
        }
        SEAM(pb + 0);
        if (PHEN(2) && IN(pb + 1)) {
            int ptid = threadIdx.x; asm volatile("" : "+v"(ptid)); const int lane = ptid & 63, wave = __builtin_amdgcn_readfirstlane(ptid >> 6), gw = vcu * NWAVES + wave; (void)lane; (void)gw; for (int m = gw; m < MP; m += 4 * NGW) { const int rows[4] = {m, m + NGW, m + 2 * NGW, m + 3 * NGW}; postproj_rows_ck<4>(P, l, rows, lane); }
            for (int m = MP + gw; m < M; m += NGW) postproj_row(P, l, m, lane); }
        SEAM(pb + 1);
        for (int rep_ = 0; rep_ < PHREP(3); ++rep_) if (PHEN(3) && IN(pb + 2)) {
            int ptid = threadIdx.x; asm volatile("" : "+v"(ptid)); const int lane = ptid & 63, wave = __builtin_amdgcn_readfirstlane(ptid >> 6), gw = vcu * NWAVES + wave; (void)lane; (void)gw;
#ifndef NO_C1
            { SEpiQs E{(bf16*)(P.ws + WS_QS), ropet, C2}; for (int r3 = 0; r3 < PHREP(13); ++r3) mid_gemm(Zb + (size_t)MP * ZW, ZW, (const bf16*)(wl + WL_WQS), QL, QL, 1280 / 64, 1, E, bx, G, (LAS char*)lds, ptid); }
#endif
            __syncthreads();
#ifndef NO_C2
            { pg8::Gemm g{Zb, (const bf16*)(wl + WL_WUQ), ZW, QL, QL}; pg8::StaticOrder S; S.init(MP / 256, 3, G, bx);
              pg8::EpiQ E{(bf16*)(P.ws + WS_QN), (bf16*)(P.ws + WS_QR), ropet, C2, SEQ - 1, (const float*)(P.ws + WS_SSQ)};
              pg8::gemm_phase<pg8::EpiQ, pg8::StaticOrder, true, true>(lds + RING_OFF, g, S, E, ptid); }
#endif
            __syncthreads();
#ifndef NO_C3
            { pg8::Gemm g{Zb + 256, (const bf16*)(wl + WL_WKV), ZW, KVL, KVL}; pg8::StaticOrder S; S.init(MP / 256, 4, G, bx);
              pg8::EpiBf16<0> E{(bf16*)(P.ws + WS_KV), 1024, nullptr};
              int ptid2 = threadIdx.x; asm volatile("" : "+v"(ptid2));
              pg8::gemm_phase<pg8::EpiBf16<0>, pg8::StaticOrder, true, true>(lds + RING_OFF, g, S, E, ptid2); }
#endif
        }
        SEAM(pb + 2);
        for (int rep_ = 0; rep_ < PHREP(4); ++rep_) if (PHEN(4) && IN(pb + 3)) {
            int ptid = threadIdx.x; asm volatile("" : "+v"(ptid)); const int lane = ptid & 63, wave = __builtin_amdgcn_readfirstlane(ptid >> 6), gw = vcu * NWAVES + wave; (void)lane; (void)gw;
            volatile LAS unsigned* qslot = (volatile LAS unsigned*)(lds + MISC_OFF) + 16;
            gu32* qctr = ctl + CW_Q + 64 * (l * 2 + rep_);
            constexpr int NITEM = DB + NB * NH * 8 + MP / CHUNK;
            for (;;) {
                if (ptid == 0) *qslot = __hip_atomic_fetch_add(qctr, 1u, RLX_AGENT);
                __syncthreads();
                const int idx = (int)*qslot;
                __syncthreads();
                if (idx >= NITEM + (PHREP(15) - 1) * NB * NH * 8) break;
                if (idx >= NITEM) { const int j = idx - NITEM; attn_unit(P, (j & 127) >> 3, j & 7, 7 - (j >> 7), (LAS char*)lds, ptid); }
                else if (idx < DB * QPER) {
                    if ((idx % QPER) == 0) { for (int r2 = 0; r2 < PHREP(10); ++r2) if (!NO_SAMPLE) sample_unit(P, l, idx / QPER, (LAS char*)lds, ptid); }
                    else { const int j = (idx / QPER) * (QPER - 1) + (idx % QPER) - 1; for (int r2 = 0; r2 < PHREP(12); ++r2) if (!NO_ATTN) attn_unit(P, (j & 127) >> 3, j & 7, 7 - (j >> 7), (LAS char*)lds, ptid); } }
                else if (idx < DB * QPER + MP / CHUNK) { for (int r2 = 0; r2 < PHREP(11); ++r2) if (!NO_GATE) gate_unit(P, l, idx - DB * QPER, (LAS char*)lds, ptid); }
                else { const int j = idx - DB - MP / CHUNK; for (int r2 = 0; r2 < PHREP(12); ++r2) if (!NO_ATTN) attn_unit(P, (j & 127) >> 3, j & 7, 7 - (j >> 7), (LAS char*)lds, ptid); }
            }
            __syncthreads();
        }
        SEAM(pb + 3);
        for (int rep_ = 0; rep_ < PHREP(5); ++rep_) if (PHEN(5) && IN(pb + 4)) {
            int ptid = threadIdx.x; asm volatile("" : "+v"(ptid)); const int lane = ptid & 63, wave = __builtin_amdgcn_readfirstlane(ptid >> 6), gw = vcu * NWAVES + wave; (void)lane; (void)gw;
            { SEpiBf16<0> E{MIXb + (size_t)MP * DM, DM, nullptr}; for (int r3 = 0; r3 < PHREP(13); ++r3) mid_gemm(AGb + (size_t)MP * DM, DM, (const bf16*)(wl + WL_WOUT), DM, DM, DM / 64, 1, E, bx, G, (LAS char*)lds, ptid); }
            __syncthreads();
            pg8::Gemm g{AGb, (const bf16*)(wl + WL_WOUT), DM, DM, DM}; pg8::StaticOrder S; S.init(MP / 256, DM / 256, G, bx);
            pg8::EpiBf16<0> E{MIXb, DM, nullptr};
            pg8::gemm_phase<pg8::EpiBf16<0>, pg8::StaticOrder, true, true>(lds + RING_OFF, g, S, E, ptid);
        }
        SEAM(pb + 4);
        for (int rep_ = 0; rep_ < ((l == 0) ? PHREP(6) : 1); ++rep_) if (PHEN(6) && IN(pb + 5)) {
            int ptid = threadIdx.x; asm volatile("" : "+v"(ptid)); const int lane = ptid & 63, wave = __builtin_amdgcn_readfirstlane(ptid >> 6), gw = vcu * NWAVES + wave; (void)lane; (void)gw;
            for (int m0 = gw; m0 < M; m0 += 2 * NGW) { RowIO io[2]; bool valid[2];
#pragma unroll
                for (int r = 0; r < 2; ++r) { const int m = m0 + r * NGW; valid[r] = m < M; const int mm = valid[r] ? m : m0;
                    io[r].xold = (l == 0) ? (mm < MP ? P.x_p + (size_t)mm * DM : P.x_s + (size_t)(mm - MP) * DM) : nullptr; io[r].xbold = Hb + (size_t)mm * DM;
                    io[r].trow = MIXb + (size_t)mm * DM; io[r].slab = nullptr; io[r].xnew = nullptr; io[r].xb = Hb + (size_t)mm * DM; io[r].rs = RSb + mm; }
                resid_rows<2>(io, valid, P.nm_post + l * DM, lane); }
        }
        SEAM(pb + 5);
        for (int rep_ = 0; rep_ < PHREP(7); ++rep_) if (PHEN(7) && IN(pb + 6)) {
            int ptid = threadIdx.x; asm volatile("" : "+v"(ptid)); const int lane = ptid & 63, wave = __builtin_amdgcn_readfirstlane(ptid >> 6), gw = vcu * NWAVES + wave; (void)lane; (void)gw;
            { SEpiBf16<2> E{Rb + (size_t)MP * DFF, DFF, nullptr}; for (int r3 = 0; r3 < PHREP(13); ++r3) mid_gemm(Hb + (size_t)MP * DM, DM, (const bf16*)(wl + WL_WUP), DM, DM, DFF / 64, 1, E, bx, G, (LAS char*)lds, ptid); }
            __syncthreads();
            pg8::Gemm g{Hb, (const bf16*)(wl + WL_WUP), DM, DM, DM}; pg8::StaticOrder S; S.init(MP / 256, DFF / 256, G, bx);
            pg8::EpiBf16<2> E{Rb, DFF, nullptr};
            pg8::gemm_phase<pg8::EpiBf16<2>, pg8::StaticOrder, true, true>(lds + RING_OFF, g, S, E, ptid);
        }
        SEAM(pb + 6);
        for (int rep_ = 0; rep_ < PHREP(8); ++rep_) if (PHEN(8) && IN(pb + 7)) {
            int ptid = threadIdx.x; asm volatile("" : "+v"(ptid)); const int lane = ptid & 63, wave = __builtin_amdgcn_readfirstlane(ptid >> 6), gw = vcu * NWAVES + wave; (void)lane; (void)gw;
            { SEpiF32Slab E{FSb}; for (int r3 = 0; r3 < PHREP(13); ++r3) mid_gemm(Rb + (size_t)MP * DFF, DFF, (const bf16*)(wl + WL_WDN), DFF, DFF / 4, DM / 64, 4, E, bx, G, (LAS char*)lds, ptid); }
            __syncthreads();
            pg8::Gemm g{Rb, (const bf16*)(wl + WL_WDN), DFF, DFF, DFF}; pg8::StaticOrder S; S.init(MP / 256, DM / 256, G, bx);
            pg8::EpiBf16<0> E{MIXb, DM, nullptr};
            pg8::gemm_phase<pg8::EpiBf16<0>, pg8::StaticOrder, true, true>(lds + RING_OFF, g, S, E, ptid);
        }
        SEAM(pb + 7);
        if (PHEN(9) && IN(pb + 8)) {
            int ptid = threadIdx.x; asm volatile("" : "+v"(ptid)); const int lane = ptid & 63, wave = __builtin_amdgcn_readfirstlane(ptid >> 6), gw = vcu * NWAVES + wave; (void)lane; (void)gw;
            for (int m0 = gw; m0 < M; m0 += 2 * NGW) { RowIO io[2]; bool valid[2];
#pragma unroll
                for (int r = 0; r < 2; ++r) { const int m = m0 + r * NGW; valid[r] = m < M; const int mm = valid[r] ? m : m0;
                    io[r].xold = nullptr; io[r].xbold = Hb + (size_t)mm * DM;
                    io[r].trow = mm < MP ? MIXb + (size_t)mm * DM : nullptr; io[r].slab = mm < MP ? nullptr : FSb + (size_t)(mm - MP) * DM;
                    io[r].xnew = (l + 1 < DEPTH) ? nullptr : P.out + (size_t)mm * DM; io[r].xb = (l + 1 < DEPTH) ? Hb + (size_t)mm * DM : nullptr; io[r].rs = RSb + mm; }
                resid_rows<2>(io, valid, P.nf_post + l * DM, lane); }
        }
        SEAM(pb + 8);
    }
#undef IN
#undef SEAM
}

extern "C" void kernel_launch(void* const* d_in, const int* in_sizes, int n_in, void* d_out, int out_size, void* d_ws, size_t ws_size, hipStream_t stream) {
    static int grid = 0;
    if (grid == 0) {
        if (n_in != 21 || (size_t)out_size != O_END || ws_size < WS_END) { fprintf(stderr, "kernel_launch: unexpected shapes: n_in %d out %d ws %zu (need %zu)\n", n_in, out_size, ws_size, (size_t)WS_END); grid = -1; return; }
        int dev = 0, cus = 0, per_cu = 0;
        if (hipGetDevice(&dev) != hipSuccess || hipDeviceGetAttribute(&cus, hipDeviceAttributeMultiprocessorCount, dev) != hipSuccess) { grid = -1; return; }
        if (hipFuncSetAttribute((const void*)fwd, hipFuncAttributeMaxDynamicSharedMemorySize, LDS_BYTES) != hipSuccess) { fprintf(stderr, "kernel_launch: hipFuncSetAttribute failed\n"); grid = -1; return; }
        if (hipOccupancyMaxActiveBlocksPerMultiprocessor(&per_cu, (const void*)fwd, NWAVES * 64, LDS_BYTES) != hipSuccess || per_cu < 1) fprintf(stderr, "kernel_launch: occupancy query reports %d\n", per_cu);
        (void)hipGetLastError();
        grid = cus;
    }
    if (grid < 0) return;
    if (hipMemsetAsync((char*)d_ws + WS_CTL, 0, CTL_ZERO_BYTES, stream) != hipSuccess) return;
    Args a{};
    Ptrs& p = a.p;
    p.x_p = (const float*)d_in[0]; p.x_s = (const float*)d_in[1]; p.cache_c = (const float*)d_in[2]; p.cache_r = (const float*)d_in[3]; p.ptab = (const int*)d_in[4];
    p.nm_pre = (const float*)d_in[5]; p.nm_post = (const float*)d_in[6]; p.w_in = (const float*)d_in[7]; p.q_norm = (const float*)d_in[8]; p.w_uq = (const float*)d_in[9];
    p.kv_norm = (const float*)d_in[10]; p.w_uk = (const float*)d_in[11]; p.w_uv = (const float*)d_in[12]; p.v_norm = (const float*)d_in[13]; p.w_sp = (const float*)d_in[14];
    p.b_sp = (const float*)d_in[15]; p.w_out = (const float*)d_in[16]; p.nf_pre = (const float*)d_in[17]; p.nf_post = (const float*)d_in[18]; p.w_up = (const float*)d_in[19]; p.w_dn = (const float*)d_in[20];
    p.out = (float*)d_out; p.ws = (unsigned char*)d_ws;
#if MK_ONE_LAUNCH
    a.ph_lo = 0; a.ph_hi = N_PHASES; a.one_launch = 1;
    hipLaunchKernelGGL(fwd, dim3(grid), dim3(NWAVES * 64), LDS_BYTES, stream, a);
#else
    for (int k = 0; k < N_PHASES; ++k) { a.ph_lo = k; a.ph_hi = k + 1; a.one_launch = 0;
        hipLaunchKernelGGL(fwd, dim3(grid), dim3(NWAVES * 64), LDS_BYTES, stream, a);
        if (hipPeekAtLastError() != hipSuccess) { fprintf(stderr, "kernel_launch: launch %d failed\n", k); break; } }
#endif
}
```

```cpp
#include <hip/hip_runtime.h>
#include <cstdio>
#include <cstdint>
#ifndef MK_ONE_LAUNCH
#define MK_ONE_LAUNCH 1
#endif
namespace pg8 {
#define PG8_LAS __attribute__((address_space(3)))
typedef unsigned short bf16_t;
typedef short bf16x8 __attribute__((ext_vector_type(8)));
typedef float f32x4 __attribute__((ext_vector_type(4)));
typedef unsigned u32x4 __attribute__((ext_vector_type(4)));
constexpr int BM = 256, BK = 64, HALF = 128, HTB = HALF * BK * 2  , STAGE_BYTES = 8 * HTB, NXCD = 8, WGM = 8;

__host__ __device__ __forceinline__ int lds_byte(int r, int c) { const int st = (r >> 4) * 2 + (c >> 5), rr = r & 15, cc = c & 31, ob = rr * 64 + cc * 2; return st * 1024 + (ob ^ (((ob >> 9) & 1) << 5)); }
__host__ __device__ __forceinline__ void stage_rc(int b, int& R, int& C) { const int st = b / 1024, sb = b % 1024, swz = sb ^ (((sb >> 9) & 1) << 5); R = (st >> 1) * 16 + swz / 64; C = (st & 1) * 32 + (swz % 64) / 2; }
__host__ __device__ __forceinline__ int perm32(int rho) { const int n = rho >> 4, i = rho & 15; return 8 * (i >> 2) + 4 * n + (i & 3); }

struct Unit { int pm, pn; };
struct Gemm { const bf16_t* A; const bf16_t* Bt; int lda, ldb, K; };

struct StaticOrder {
    int nM, nN, nwg, G, c;
    __host__ __device__ void init(int nM_, int nN_, int G_, int c_) { nM = nM_; nN = nN_; nwg = nM * nN; G = G_; c = c_; }
    __host__ __device__ bool next(int i, Unit& u) const {
        const long L = (long)i * G + c; if (L >= nwg) return false;
        int wgid = (int)L; { const int q = nwg / NXCD, r = nwg % NXCD, xcd = wgid % NXCD, off = wgid / NXCD; wgid = (xcd < r ? xcd * (q + 1) : r * (q + 1) + (xcd - r) * q) + off; }
        const int nig = WGM * nN, gid = wgid / nig, fm = gid * WGM, gsz = (nM - fm) < WGM ? (nM - fm) : WGM;
        u.pm = fm + ((wgid % nig) % gsz); u.pn = (wgid % nig) / gsz; return true;
    }
    __device__ __forceinline__ void a_ready(const Unit&) const {}
    __device__ __forceinline__ void done(const Unit&) const {}
};

__device__ __forceinline__ unsigned cvt_pk_bf16(float lo, float hi) { unsigned r; asm volatile("v_cvt_pk_bf16_f32 %0, %1, %2" : "=v"(r) : "v"(lo), "v"(hi)); return r; }

template <int ACT  > struct EpiBf16 {
    static constexpr bool PERM = true, AFTER_DRAIN = false;
    bf16_t* O; int ldc; const float* rs;
    __device__ __forceinline__ void operator()(const f32x4 (&acc)[2][2][4][2], const Unit& u, int wr, int wc, int fr, int fq) const {
        const int row0 = u.pm * BM + wr * 64 + fr; const int col0 = u.pn * BM + wc * 32 + 8 * fq;
#pragma unroll
        for (int ai = 0; ai < 2; ++ai)
#pragma unroll
            for (int m = 0; m < 4; ++m) { bf16_t* rowp = O + (size_t)(row0 + ai * HALF + m * 16) * ldc + col0; const float rsc = rs ? rs[row0 + ai * HALF + m * 16] : 1.0f;
#pragma unroll
                for (int bj = 0; bj < 2; ++bj) { f32x4 v0 = acc[ai][bj][m][0] * rsc, v1 = acc[ai][bj][m][1] * rsc;
                    if (ACT == 2) {
#pragma unroll
                        for (int e = 0; e < 4; ++e) { float a = v0[e] > 0.f ? v0[e] : 0.f; v0[e] = a * a; float b = v1[e] > 0.f ? v1[e] : 0.f; v1[e] = b * b; } }
                    u32x4 w; w.x = cvt_pk_bf16(v0[0], v0[1]); w.y = cvt_pk_bf16(v0[2], v0[3]); w.z = cvt_pk_bf16(v1[0], v1[1]); w.w = cvt_pk_bf16(v1[2], v1[3]);
                    *(u32x4*)(rowp + bj * HALF) = w; } }
    }
};

struct EpiZ {
    static constexpr bool PERM = true, AFTER_DRAIN = false;
    bf16_t* O; int ldc; float* ssq; float* ssv;
    __device__ __forceinline__ void operator()(const f32x4 (&acc)[2][2][4][2], const Unit& u, int wr, int wc, int fr, int fq) const {
        const int row0 = u.pm * BM + wr * 64 + fr; const int col0 = u.pn * BM + wc * 32 + 8 * fq;
        const bool doq = u.pn == 0, dov = u.pn >= 4;
#pragma unroll
        for (int ai = 0; ai < 2; ++ai)
#pragma unroll
            for (int m = 0; m < 4; ++m) { const int row = row0 + ai * HALF + m * 16; bf16_t* rowp = O + (size_t)row * ldc + col0; float s = 0.f;
#pragma unroll
                for (int bj = 0; bj < 2; ++bj) { const f32x4 v0 = acc[ai][bj][m][0], v1 = acc[ai][bj][m][1];
                    s += (v0[0] * v0[0] + v0[1] * v0[1]) + (v0[2] * v0[2] + v0[3] * v0[3]) + (v1[0] * v1[0] + v1[1] * v1[1]) + (v1[2] * v1[2] + v1[3] * v1[3]);
                    u32x4 w; w.x = cvt_pk_bf16(v0[0], v0[1]); w.y = cvt_pk_bf16(v0[2], v0[3]); w.z = cvt_pk_bf16(v1[0], v1[1]); w.w = cvt_pk_bf16(v1[2], v1[3]);
                    *(u32x4*)(rowp + bj * HALF) = w; }
                if (doq || dov) { s += __shfl_xor(s, 16); s += __shfl_xor(s, 32);
                    if (fq == 0) { float* d = doq ? ssq + (size_t)row * 4 + wc : ssv + (size_t)row * 8 + (u.pn - 4) * 4 + wc; *d = s; } } }
    }
};

struct EpiQ {
    static constexpr bool PERM = true, AFTER_DRAIN = false;
    bf16_t* Qn; bf16_t* Qr; const float* tab; float sc; int tmask; const float* ssq;
    __device__ __forceinline__ void operator()(const f32x4 (&acc)[2][2][4][2], const Unit& u, int wr, int wc, int fr, int fq) const {
        const int row0 = u.pm * BM + wr * 64 + fr;
        if (u.pn < 2) {
            const int col0 = u.pn * BM + wc * 32 + 8 * fq;
#pragma unroll
            for (int ai = 0; ai < 2; ++ai)
#pragma unroll
                for (int m = 0; m < 4; ++m) { const int row = row0 + ai * HALF + m * 16; bf16_t* rowp = Qn + (size_t)row * 512 + col0;
                    const f32x4 pq = *(const f32x4*)(ssq + (size_t)row * 4); const float scr = sc / sqrtf(((pq[0] + pq[1]) + (pq[2] + pq[3])) * (1.0f / 256.0f) + 1e-6f);
#pragma unroll
                    for (int bj = 0; bj < 2; ++bj) { const f32x4 v0 = acc[ai][bj][m][0] * scr, v1 = acc[ai][bj][m][1] * scr;
                        u32x4 w; w.x = cvt_pk_bf16(v0[0], v0[1]); w.y = cvt_pk_bf16(v0[2], v0[3]); w.z = cvt_pk_bf16(v1[0], v1[1]); w.w = cvt_pk_bf16(v1[2], v1[3]);
                        *(u32x4*)(rowp + bj * HALF) = w; } }
        } else {
            const int col0 = wc * 32 + 8 * fq;
#pragma unroll
            for (int ai = 0; ai < 2; ++ai)
#pragma unroll
                for (int m = 0; m < 4; ++m) { const int row = row0 + ai * HALF + m * 16; bf16_t* rowp = Qr + (size_t)row * 256 + col0;
                    const f32x4* tp = (const f32x4*)(tab + (size_t)(row & tmask) * 32 + 8 * fq);
                    const f32x4 t0 = tp[0], t1 = tp[1];
                    const f32x4 pq = *(const f32x4*)(ssq + (size_t)row * 4); const float sc = this->sc / sqrtf(((pq[0] + pq[1]) + (pq[2] + pq[3])) * (1.0f / 256.0f) + 1e-6f);
#pragma unroll
                    for (int bj = 0; bj < 2; ++bj) { const f32x4 v0 = acc[ai][bj][m][0], v1 = acc[ai][bj][m][1];
                        const float a0 = (v0[0] * t0[0] - v0[1] * t0[1]) * sc, a1 = (v0[1] * t0[0] + v0[0] * t0[1]) * sc;
                        const float a2 = (v0[2] * t0[2] - v0[3] * t0[3]) * sc, a3 = (v0[3] * t0[2] + v0[2] * t0[3]) * sc;
                        const float a4 = (v1[0] * t1[0] - v1[1] * t1[1]) * sc, a5 = (v1[1] * t1[0] + v1[0] * t1[1]) * sc;
                        const float a6 = (v1[2] * t1[2] - v1[3] * t1[3]) * sc, a7 = (v1[3] * t1[2] + v1[2] * t1[3]) * sc;
                        u32x4 w; w.x = cvt_pk_bf16(a0, a1); w.y = cvt_pk_bf16(a2, a3); w.z = cvt_pk_bf16(a4, a5); w.w = cvt_pk_bf16(a6, a7);
                        *(u32x4*)(rowp + bj * HALF) = w; }
                    asm volatile("" ::: "memory"); }
        }
    }
};

template <class Epi, class Sched, bool ALIGN_EPI = false, bool SP2 = false>
__device__ __forceinline__ void gemm_phase(PG8_LAS unsigned char* lds, const Gemm g, const Sched& S, const Epi& E, const int tid) {
    const int wid = __builtin_amdgcn_readfirstlane(tid >> 6), lane = tid & 63, wr = wid >> 2, wc = wid & 3, fr = lane & 15, fq = lane >> 4;
    int K_ = g.K; asm volatile("" : "+s"(K_));
    const int K = K_, nt = K / BK;
    unsigned voffA[2], voffB[2];
#pragma unroll
    for (int i = 0; i < 2; ++i) { int R, C; stage_rc(tid * 16 + i * 8192, R, C); const int Rb = Epi::PERM ? ((R & ~31) + perm32(R & 31)) : R;
        voffA[i] = (unsigned)(R * g.lda + C) * 2u; voffB[i] = (unsigned)(Rb * g.ldb + C) * 2u; }
    const size_t kstep = (size_t)(BK * 2);
    const size_t hstepA = (size_t)HALF * g.lda * 2, hstepB = (size_t)HALF * g.ldb * 2;
    const size_t tstepA = 2 * hstepA, tstepB = 2 * hstepB;
    const unsigned ldsw = (unsigned)wid * 1024u;
    const int aoff = lds_byte(wr * 64 + fr, fq * 8), boff = lds_byte(wc * 32 + fr, fq * 8);
#define PG8_SA(b, h) (((b) * 2 + (h)) * HTB)
#define PG8_SB(b, h) ((4 + (b) * 2 + (h)) * HTB)
#define PG8_STAGE(bufoff, gbase, voff) do { _Pragma("unroll") for (int _i = 0; _i < 2; ++_i) \
        __builtin_amdgcn_global_load_lds((const unsigned*)((const char*)(gbase) + (voff)[_i]), (PG8_LAS unsigned*)(lds + (bufoff) + ldsw + _i * 8192), 16, 0, 0); } while (0)
#define PG8_LDA(dst, b, h) do { _Pragma("unroll") for (int m = 0; m < 4; ++m) _Pragma("unroll") for (int k = 0; k < 2; ++k) dst[m][k] = *(const PG8_LAS bf16x8*)(lds + PG8_SA(b, h) + aoff + m * 2048 + k * 1024); } while (0)
#define PG8_LDB(dst, b, h) do { _Pragma("unroll") for (int n = 0; n < 2; ++n) _Pragma("unroll") for (int k = 0; k < 2; ++k) dst[n][k] = *(const PG8_LAS bf16x8*)(lds + PG8_SB(b, h) + boff + n * 2048 + k * 1024); } while (0)
#define PG8_MMA(ai, bj, At, Bt) do { __builtin_amdgcn_s_setprio(1); _Pragma("unroll") for (int m = 0; m < 4; ++m) _Pragma("unroll") for (int n = 0; n < 2; ++n) _Pragma("unroll") for (int k = 0; k < 2; ++k) \
        acc[ai][bj][m][n] = __builtin_amdgcn_mfma_f32_16x16x32_bf16(Bt[n][k], At[m][k], acc[ai][bj][m][n], 0, 0, 0); __builtin_amdgcn_s_setprio(0); } while (0)
#define PG8_WAIT_V(n) asm volatile("s_waitcnt vmcnt(" #n ")" ::: "memory")
#define PG8_WAIT_L(n) asm volatile("s_waitcnt lgkmcnt(" #n ")" ::: "memory")
#define PG8_BAR __builtin_amdgcn_s_barrier()
#define PG8_SCHED __builtin_amdgcn_sched_barrier(0)
    Unit cur, nxt; int ui = 0;
    if (!S.next(0, cur)) return;
    f32x4 acc[2][2][4][2];
#pragma unroll
    for (int a = 0; a < 2; ++a)
#pragma unroll
        for (int b = 0; b < 2; ++b)
#pragma unroll
            for (int m = 0; m < 4; ++m)
#pragma unroll
                for (int n = 0; n < 2; ++n) acc[a][b][m][n] = (f32x4){0.f, 0.f, 0.f, 0.f};
    bf16x8 At[4][2], B0[2][2], B1[2][2];
    const char* cA = (const char*)g.A + (size_t)cur.pm * tstepA; const char* cB = (const char*)g.Bt + (size_t)cur.pn * tstepB;
    S.a_ready(cur);
    if constexpr (SP2) {
        PG8_STAGE(PG8_SB(0, 0), cB, voffB); PG8_STAGE(PG8_SB(0, 1), cB + hstepB, voffB); PG8_STAGE(PG8_SA(0, 0), cA, voffA); PG8_STAGE(PG8_SA(0, 1), cA + hstepA, voffA);
        if (wr == 1) PG8_BAR;
        PG8_WAIT_V(2); PG8_BAR;
        PG8_STAGE(PG8_SB(1, 0), cB + kstep, voffB); PG8_STAGE(PG8_SA(1, 0), cA + kstep, voffA); PG8_STAGE(PG8_SB(1, 1), cB + hstepB + kstep, voffB);
        PG8_WAIT_V(6); PG8_BAR;
    } else {
        PG8_STAGE(PG8_SB(0, 0), cB, voffB); PG8_STAGE(PG8_SA(0, 0), cA, voffA); PG8_STAGE(PG8_SB(0, 1), cB + hstepB, voffB); PG8_STAGE(PG8_SA(0, 1), cA + hstepA, voffA);
        if (wr == 1) PG8_BAR;
        PG8_WAIT_V(4); PG8_BAR;
        PG8_STAGE(PG8_SB(1, 0), cB + kstep, voffB); PG8_STAGE(PG8_SA(1, 0), cA + kstep, voffA); PG8_STAGE(PG8_SB(1, 1), cB + hstepB + kstep, voffB);
        PG8_WAIT_V(6); PG8_BAR;
    }
    for (;;) {
        const bool has_next = S.next(ui + 1, nxt);
        const char* nA = has_next ? (const char*)g.A + (size_t)nxt.pm * tstepA : cA; const char* nB = has_next ? (const char*)g.Bt + (size_t)nxt.pn * tstepB : cB;
#pragma unroll 1
        for (int t = 0; t < nt; t += 2) {
            const bool last = (t == nt - 2);
            const char* a1 = cA + (size_t)(t + 1) * kstep;
            const char* a2 = last ? nA : cA + (size_t)(t + 2) * kstep; const char* b2 = last ? nB : cB + (size_t)(t + 2) * kstep;
            const char* a3 = a2 + kstep; const char* b3 = b2 + kstep;
            if (last && has_next) S.a_ready(nxt);
            if constexpr (SP2) {
            PG8_LDB(B0, 0, 0); PG8_LDB(B1, 0, 1); PG8_SCHED; PG8_LDA(At, 0, 0); PG8_STAGE(PG8_SA(1, 1), a1 + hstepA, voffA);
            PG8_WAIT_V(8); PG8_WAIT_L(0); PG8_BAR; PG8_MMA(0, 0, At, B0); PG8_MMA(0, 1, At, B1); PG8_BAR; PG8_SCHED;
            PG8_LDA(At, 0, 1); PG8_STAGE(PG8_SB(0, 0), b2, voffB); PG8_STAGE(PG8_SB(0, 1), b2 + hstepB, voffB); PG8_STAGE(PG8_SA(0, 0), a2, voffA);
            PG8_WAIT_V(8); PG8_WAIT_L(0); PG8_BAR; PG8_MMA(1, 0, At, B0); PG8_MMA(1, 1, At, B1); PG8_BAR; PG8_SCHED;
            PG8_LDB(B0, 1, 0); PG8_LDB(B1, 1, 1); PG8_SCHED; PG8_LDA(At, 1, 0); PG8_STAGE(PG8_SA(0, 1), a2 + hstepA, voffA);
            PG8_WAIT_V(8); PG8_WAIT_L(0); PG8_BAR; PG8_MMA(0, 0, At, B0); PG8_MMA(0, 1, At, B1); PG8_BAR; PG8_SCHED;
            PG8_LDA(At, 1, 1); PG8_STAGE(PG8_SB(1, 0), b3, voffB); PG8_STAGE(PG8_SB(1, 1), b3 + hstepB, voffB); PG8_STAGE(PG8_SA(1, 0), a3, voffA);
            PG8_WAIT_V(8); PG8_WAIT_L(0); PG8_BAR; PG8_MMA(1, 0, At, B0); PG8_MMA(1, 1, At, B1); PG8_BAR; PG8_SCHED;
            } else {
            PG8_LDB(B0, 0, 0); PG8_SCHED; PG8_LDA(At, 0, 0); PG8_STAGE(PG8_SA(1, 1), a1 + hstepA, voffA);
            PG8_WAIT_L(8); PG8_BAR; PG8_WAIT_L(0); PG8_MMA(0, 0, At, B0); PG8_BAR; PG8_SCHED;
            PG8_LDB(B1, 0, 1); PG8_STAGE(PG8_SB(0, 0), b2, voffB);
            PG8_BAR; PG8_WAIT_L(0); PG8_MMA(0, 1, At, B1); PG8_BAR;
            PG8_LDA(At, 0, 1); PG8_STAGE(PG8_SA(0, 0), a2, voffA);
            PG8_BAR; PG8_WAIT_L(0); PG8_MMA(1, 0, At, B0); PG8_BAR; PG8_SCHED;
            PG8_STAGE(PG8_SB(0, 1), b2 + hstepB, voffB);
            PG8_WAIT_V(6); PG8_BAR; PG8_MMA(1, 1, At, B1); PG8_BAR;
            PG8_LDB(B0, 1, 0); PG8_SCHED; PG8_LDA(At, 1, 0); PG8_STAGE(PG8_SA(0, 1), a2 + hstepA, voffA);
            PG8_WAIT_L(8); PG8_BAR; PG8_WAIT_L(0); PG8_MMA(0, 0, At, B0); PG8_BAR; PG8_SCHED;
            PG8_LDB(B1, 1, 1); PG8_STAGE(PG8_SB(1, 0), b3, voffB);
            PG8_BAR; PG8_WAIT_L(0); PG8_MMA(0, 1, At, B1); PG8_BAR;
            PG8_LDA(At, 1, 1); PG8_STAGE(PG8_SA(1, 0), a3, voffA);
            PG8_BAR; PG8_WAIT_L(0); PG8_MMA(1, 0, At, B0); PG8_BAR; PG8_SCHED;
            PG8_STAGE(PG8_SB(1, 1), b3 + hstepB, voffB);
            PG8_WAIT_V(6); PG8_BAR; PG8_MMA(1, 1, At, B1); PG8_BAR;
            }
        }
        if constexpr (ALIGN_EPI) { if (wr == 0) PG8_BAR; }
        if constexpr (!Epi::AFTER_DRAIN) { E(acc, cur, wr, wc, fr, fq); S.done(cur); }
        if (!has_next) break;
#pragma unroll
        for (int a = 0; a < 2; ++a)
#pragma unroll
            for (int b = 0; b < 2; ++b)
#pragma unroll
                for (int m = 0; m < 4; ++m)
#pragma unroll
                    for (int n = 0; n < 2; ++n) acc[a][b][m][n] = (f32x4){0.f, 0.f, 0.f, 0.f};
        cur = nxt; cA = nA; cB = nB; ++ui;
        if constexpr (ALIGN_EPI) { if (wr == 1) PG8_BAR; }
    }
    PG8_WAIT_V(0);
    if constexpr (!ALIGN_EPI) { if (wr == 0) PG8_BAR; }
    PG8_BAR;
#undef PG8_SA
#undef PG8_SB
#undef PG8_STAGE
#undef PG8_LDA
#undef PG8_LDB
#undef PG8_MMA
#undef PG8_WAIT_V
#undef PG8_WAIT_L
#undef PG8_BAR
#undef PG8_SCHED
}
}
constexpr int DM = 1024, NB = 16, SEQ = 2048, DEPTH = 2, DB = 128, DT = 4, PAST = 8192, PAGE = 128;
constexpr int NH = 8, NOPE = 64, ROPE = 32, VD = 64, QL = 256, KVL = 128, GMW = 512, CHUNK = 128;
constexpr int INW = 1440, ZW = 1536, DFF = 4096;
constexpr int MP = NB * SEQ, MS = DB * DT, M = MP + MS;
constexpr int NPAGES = PAST / PAGE, NPHYS = (DB * NPAGES * 5) / 4;
constexpr float EPS = 1e-6f;
constexpr float C2 = 0.10206207261596575f * 1.4426950408889634f;
constexpr int NPOS = SEQ + DT;

constexpr size_t O_Y = 0;
constexpr size_t O_CKV_P = (size_t)M * DM;
constexpr size_t O_KR_P = O_CKV_P + (size_t)DEPTH * MP * KVL;
constexpr size_t O_CKV_S = O_KR_P + (size_t)DEPTH * MP * ROPE;
constexpr size_t O_KR_S = O_CKV_S + (size_t)DEPTH * MS * KVL;
constexpr size_t O_V_S = O_KR_S + (size_t)DEPTH * MS * ROPE;
constexpr size_t O_END = O_V_S + (size_t)DEPTH * MS * GMW;

constexpr size_t MiB = 1u << 20;
constexpr size_t WS_CTL = 0, CTL_ZERO_BYTES = 1 * MiB;
constexpr size_t WS_WL = 2 * MiB, WL_STRIDE = 24 * MiB;
constexpr size_t WL_WIN = 0, WL_WUQ = 3 * MiB, WL_WQS = 3 * MiB + 512 * 1024, WL_WKV = 4 * MiB + 256 * 1024, WL_WSP = 4 * MiB + 512 * 1024,
                 WL_WOUT = 5 * MiB, WL_WUP = 7 * MiB, WL_WDN = 15 * MiB;
constexpr size_t WS_ROPE = 50 * MiB;
constexpr size_t WS_SSQ = 60 * MiB, WS_SSV = 61 * MiB;
constexpr size_t WS_RS = 62 * MiB;
constexpr size_t WS_H = 64 * MiB;
constexpr size_t WS_Z = 130 * MiB;
constexpr size_t WS_QN = 228 * MiB, WS_QR = 260 * MiB;
constexpr size_t WS_KV = 276 * MiB;
constexpr size_t WS_QS = 340 * MiB;
constexpr size_t WS_AG = 342 * MiB;
constexpr size_t WS_MIX = 408 * MiB;
constexpr size_t WS_FS = 474 * MiB;
constexpr size_t WS_R = 484 * MiB;
constexpr size_t WS_END = 746 * MiB;

constexpr int CW_TMO = 0, CW_CODE = 1;
constexpr int CW_BAR = 4096;
constexpr int CW_Q = 8192;

constexpr int RING_OFF = 0, RING_BYTES = 131072;
constexpr int LDSCTL_OFF = RING_BYTES, MISC_OFF = LDSCTL_OFF + 320;
constexpr int LDS_BYTES = 147456;

#define GAS __attribute__((address_space(1)))
#define LAS __attribute__((address_space(3)))
typedef unsigned short bf16;
typedef unsigned v4u __attribute__((ext_vector_type(4)));
typedef unsigned v2u __attribute__((ext_vector_type(2)));
typedef float f32x4 __attribute__((ext_vector_type(4)));
typedef float f32x2 __attribute__((ext_vector_type(2)));
typedef float f32x16 __attribute__((ext_vector_type(16)));
typedef short bf16x8 __attribute__((ext_vector_type(8)));
typedef short s16x4 __attribute__((ext_vector_type(4)));
typedef GAS unsigned gu32;
#define RLX_AGENT __ATOMIC_RELAXED, __HIP_MEMORY_SCOPE_AGENT
#define LDS_WAIT() asm volatile("s_waitcnt lgkmcnt(0)" ::: "memory")
#define VM_WAIT() asm volatile("s_waitcnt vmcnt(0)" ::: "memory")
__device__ __forceinline__ unsigned f2bf(float f) { unsigned u = __builtin_bit_cast(unsigned, f); return (u + 0x7fffu + ((u >> 16) & 1u)) >> 16; }
__device__ __forceinline__ unsigned pk2(float lo, float hi) { return f2bf(lo) | (f2bf(hi) << 16); }
__device__ __forceinline__ float bflo(unsigned w) { return __builtin_bit_cast(float, w << 16); }
__device__ __forceinline__ float bfhi(unsigned w) { return __builtin_bit_cast(float, w & 0xffff0000u); }
__device__ __forceinline__ float bf2f(bf16 h) { return __builtin_bit_cast(float, (unsigned)h << 16); }
__device__ __forceinline__ int crow(int r, int hi) { return (r & 3) + 8 * (r >> 2) + 4 * hi; }
__device__ __forceinline__ float wave_sum(float v) {
#pragma unroll
    for (int o = 1; o < 64; o <<= 1) v += __shfl_xor(v, o);
    return v;
}
__device__ __forceinline__ s16x4 vtr(const LAS char* p) { return __builtin_bit_cast(s16x4, __builtin_amdgcn_ds_read_tr16_b64_v4i16((LAS s16x4*)p)); }
__device__ __forceinline__ bf16x8 cat8(s16x4 a, s16x4 b) { return (bf16x8){a[0], a[1], a[2], a[3], b[0], b[1], b[2], b[3]}; }
__device__ __forceinline__ bf16x8 pack8(float a0, float a1, float a2, float a3, float a4, float a5, float a6, float a7) {
    v4u w; w.x = pg8::cvt_pk_bf16(a0, a1); w.y = pg8::cvt_pk_bf16(a2, a3); w.z = pg8::cvt_pk_bf16(a4, a5); w.w = pg8::cvt_pk_bf16(a6, a7); return __builtin_bit_cast(bf16x8, w); }

struct Ptrs {
    const float *x_p, *x_s, *cache_c, *cache_r; const int* ptab;
    const float *nm_pre, *nm_post, *w_in, *q_norm, *w_uq, *kv_norm, *w_uk, *w_uv, *v_norm, *w_sp, *b_sp, *w_out, *nf_pre, *nf_post, *w_up, *w_dn;
    float* out; unsigned char* ws;
};

template <int MODE>
__device__ __forceinline__ int dest_row(int n, int row_off) {
    if (MODE == 0) return row_off + n;
    if (MODE == 1) return n < 416 ? n : n + 96;
    const int h = n / 96, e = n - h * 96;
    if (MODE == 2) return e < 64 ? h * 64 + e : 512 + h * 32 + 2 * ((e - 64) & 15) + ((e - 64) >> 4);
    return e >= 64 ? 1024 + h * 32 + (e - 64) : -1;
}
template <int MODE>
__device__ __forceinline__ void p0_transpose_item(const float* W, int K, int N, bf16* WT, int row_off, LAS float* scr, int item, int lane, const float* gk = nullptr) {
    const int nblk = N / 32, kb = item / nblk, nb = item % nblk, k0 = 64 * kb, n0 = 32 * nb;
    {
        f32x4 w[8];
#pragma unroll
        for (int i = 0; i < 8; ++i) { const int kk = 8 * i + (lane >> 3); w[i] = *(const GAS f32x4*)(W + (size_t)(k0 + kk) * N + n0 + 4 * (lane & 7)); }
#pragma unroll
        for (int i = 0; i < 8; ++i) { const int kk = 8 * i + (lane >> 3); LAS float* d = scr + kk * 33 + 4 * (lane & 7); d[0] = w[i].x; d[1] = w[i].y; d[2] = w[i].z; d[3] = w[i].w; }
    }
    LDS_WAIT(); asm volatile("" ::: "memory");
    const int c = lane & 7;
    float gv[8];
#pragma unroll
    for (int e = 0; e < 8; ++e) gv[e] = gk ? gk[k0 + 8 * c + e] : 1.0f;
#pragma unroll
    for (int j = 0; j < 4; ++j) { const int n = (lane >> 3) + 8 * j; const LAS float* s = scr + (8 * c) * 33 + n;
        const float v0 = s[0 * 33], v1 = s[1 * 33], v2 = s[2 * 33], v3 = s[3 * 33], v4 = s[4 * 33], v5 = s[5 * 33], v6 = s[6 * 33], v7 = s[7 * 33];
        v4u o; o.x = pk2(v0 * gv[0], v1 * gv[1]); o.y = pk2(v2 * gv[2], v3 * gv[3]); o.z = pk2(v4 * gv[4], v5 * gv[5]); o.w = pk2(v6 * gv[6], v7 * gv[7]);
        const int dr = dest_row<MODE>(n0 + n, row_off);
        if (dr >= 0) *(GAS v4u*)(WT + (size_t)dr * K + k0 + 8 * c) = o;
        if (MODE == 2) { const int dr2 = dest_row<3>(n0 + n, 0);
            if (dr2 >= 0) { v4u o2; o2.x = pk2(v0, v1); o2.y = pk2(v2, v3); o2.z = pk2(v4, v5); o2.w = pk2(v6, v7); *(GAS v4u*)(WT + (size_t)(WL_WQS - WL_WUQ) / 2 + (size_t)dr2 * K + k0 + 8 * c) = o2; } } }
    LDS_WAIT(); asm volatile("" ::: "memory");
}

__device__ __forceinline__ void rope_entry(int pos, int i, float& c, float& s) {
    const double f = exp2(-(double)i * (13.287712379549449 / 16.0));
    const double f2 = f * f; double cs = 1.0, sn = f, tc = 1.0, ts = f;
#pragma unroll 1
    for (int k = 1; k <= 12; ++k) { tc *= -f2 / (double)((2 * k - 1) * (2 * k)); ts *= -f2 / (double)((2 * k) * (2 * k + 1)); cs += tc; sn += ts; }
    double rc = 1.0, rs = 0.0, bc = cs, bs = sn; int p = pos;
#pragma unroll 1
    for (int b = 0; b < 14; ++b) { if (p & 1) { const double nc = rc * bc - rs * bs, ns = rc * bs + rs * bc; rc = nc; rs = ns; }
        const double nbc = bc * bc - bs * bs, nbs = 2.0 * bc * bs; bc = nbc; bs = nbs; p >>= 1; }
    c = (float)rc; s = (float)rs;
}

template <int NR>
__device__ __forceinline__ void rows_to_bf16_rs(const float* const (&xrow)[NR], bf16* const (&orow)[NR], float* const (&rs)[NR], const bool (&valid)[NR], int lane) {
    f32x4 v[NR][4];
#pragma unroll
    for (int r = 0; r < NR; ++r) if (valid[r]) {
#pragma unroll
        for (int jj = 0; jj < 2; ++jj) { const GAS f32x4* xr = (const GAS f32x4*)(xrow[r] + jj * 512 + 8 * lane); v[r][2 * jj] = xr[0]; v[r][2 * jj + 1] = xr[1]; } }
#pragma unroll
    for (int r = 0; r < NR; ++r) if (valid[r]) {
        float s = 0.f;
#pragma unroll
        for (int j = 0; j < 4; ++j) s += (v[r][j].x * v[r][j].x + v[r][j].y * v[r][j].y) + (v[r][j].z * v[r][j].z + v[r][j].w * v[r][j].w);
        const float rstd = 1.0f / sqrtf(wave_sum(s) * (1.f / DM) + EPS);
        if (lane == 0) *rs[r] = rstd;
#pragma unroll
        for (int jj = 0; jj < 2; ++jj) { const f32x4 a = v[r][2 * jj] * rstd, b2 = v[r][2 * jj + 1] * rstd;
            v4u o; o.x = pk2(a.x, a.y); o.y = pk2(a.z, a.w); o.z = pk2(b2.x, b2.y); o.w = pk2(b2.z, b2.w);
            *(GAS v4u*)(orow[r] + jj * 512 + 8 * lane) = o; } }
}

template <class Epi>
__device__ __forceinline__ void small_gemm(const bf16* A, int lda, const bf16* Bt, int ldb, int Kper, int ntn, int KS, const Epi& E, int gw, int ngw, int lane) {
    const int r32 = lane & 31, hi = lane >> 5;
    const int nitem = 16 * ntn * KS;
    for (int item = gw; item < nitem; item += ngw) {
        const int tm = item & 15, rest = item >> 4, tn = rest % ntn, ks = rest / ntn;
        const bf16* ap = A + (size_t)(tm * 32 + r32) * lda + ks * Kper + hi * 8;
        const bf16* bp = Bt + (size_t)(tn * 32 + r32) * ldb + ks * Kper + hi * 8;
        f32x16 acc = {};
#pragma unroll 1
        for (int k = 0; k < Kper; k += 128) {
            bf16x8 a[8], b[8];
#pragma unroll
            for (int j = 0; j < 8; ++j) { a[j] = *(const GAS bf16x8*)(ap + k + j * 16); b[j] = *(const GAS bf16x8*)(bp + k + j * 16); }
#pragma unroll
            for (int j = 0; j < 8; ++j) acc = __builtin_amdgcn_mfma_f32_32x32x16_bf16(b[j], a[j], acc, 0, 0, 0);
        }
        E(acc, tm * 32 + r32, tn * 32, ks, hi);
    }
}
template <int ACT> struct SEpiBf16 {
    bf16* O; int ldc; const float* rs;
    __device__ __forceinline__ void operator()(const f32x16& acc, int row, int col0, int ks, int hi) const {
        bf16* rp = O + (size_t)row * ldc + col0 + 4 * hi; const float rsc = rs ? rs[row] : 1.0f;
#pragma unroll
        for (int q = 0; q < 4; ++q) { float v[4];
#pragma unroll
            for (int e = 0; e < 4; ++e) { float x = acc[4 * q + e] * rsc; if (ACT == 2) { x = x > 0.f ? x : 0.f; x = x * x; } v[e] = x; }
            v2u w; w.x = pk2(v[0], v[1]); w.y = pk2(v[2], v[3]); *(GAS v2u*)(rp + 8 * q) = w; }
    }
};
struct SEpiF32Slab {
    float* O;
    __device__ __forceinline__ void operator()(const f32x16& acc, int row, int col0, int ks, int hi) const {
        float* rp = O + ((size_t)ks * MS + row) * DM + col0 + 4 * hi;
#pragma unroll
        for (int q = 0; q < 4; ++q) *(GAS f32x4*)(rp + 8 * q) = (f32x4){acc[4 * q], acc[4 * q + 1], acc[4 * q + 2], acc[4 * q + 3]};
    }
};
struct SEpiQs {
    bf16* O; const float* tab; float sc;
    __device__ __forceinline__ void operator()(const f32x16& acc, int row, int col0, int ks, int hi) const {
        bf16* rp = O + (size_t)row * 1280 + col0 + 4 * hi;
        float v[16];
        if (col0 < 1024) {
#pragma unroll
            for (int r = 0; r < 16; ++r) v[r] = acc[r] * sc;
        } else {
            const float* tp = tab + (size_t)(SEQ + (row & 3)) * 32;
#pragma unroll
            for (int r = 0; r < 8; ++r) { const int i = crow(r, hi); const float c = tp[2 * i], s = tp[2 * i + 1]; const float x1 = acc[r], x2 = acc[r + 8];
                v[r] = (x1 * c - x2 * s) * sc; v[r + 8] = (x2 * c + x1 * s) * sc; }
        }
#pragma unroll
        for (int q = 0; q < 4; ++q) { v2u w; w.x = pk2(v[4 * q], v[4 * q + 1]); w.y = pk2(v[4 * q + 2], v[4 * q + 3]); *(GAS v2u*)(rp + 8 * q) = w; }
    }
};
#define XB_TMO      128
#define XB_XCNT(j)  (256  + 64 * (j))
#define XB_XSUB(j)  (1280 + 64 * (j))
#define XB_XGEN(j)  (2304 + 64 * (j))
#define XB_TOP      3328
#define XB_TOPGEN   3392
#define XCD_BAR_WORDS 3456
#define XB_SPIN_CAP (1u << 18)

__device__ __forceinline__ unsigned xb_ld(unsigned* p)              { return __hip_atomic_load(p, __ATOMIC_RELAXED, __HIP_MEMORY_SCOPE_AGENT); }
__device__ __forceinline__ unsigned xb_add(unsigned* p, unsigned v) { return __hip_atomic_fetch_add(p, v, __ATOMIC_RELAXED, __HIP_MEMORY_SCOPE_AGENT); }
__device__ __forceinline__ unsigned xb_xcc_id() { return (unsigned)__builtin_amdgcn_s_getreg((3 << 11) | 20) & 0xFu; }
#define XB_SPIN(cond, bar) do { unsigned _sp = 0; while (cond) { __builtin_amdgcn_s_sleep(1); \
    if ((++_sp & 255u) == 0u) { if (xb_ld(&(bar)[XB_TMO])) break; if (_sp > XB_SPIN_CAP) { atomicAdd(&(bar)[XB_TMO], 1u); break; } } } } while (0)

struct XcdBarrier {
    unsigned* bar; unsigned x;
    volatile LAS unsigned* st;
};

__device__ __forceinline__ XcdBarrier xcd_barrier_post(unsigned* bar, volatile LAS unsigned* st) {
    XcdBarrier b; b.bar = bar; b.x = xb_xcc_id(); b.st = st;
    if (threadIdx.x == 0) (void)xb_add(&bar[XB_XCNT(b.x)], 1u);
    return b;
}
__device__ __forceinline__ void xcd_barrier_complete(unsigned* bar, unsigned x, unsigned& nloc, unsigned& nx) {
    const unsigned G = gridDim.x * gridDim.y * gridDim.z;
    unsigned sum, cnt, mine, sp = 0u;
    for (;;) {
        sum = 0u; cnt = 0u; mine = 0u;
#pragma unroll
        for (unsigned j = 0; j < 16; ++j) { const unsigned c = xb_ld(&bar[XB_XCNT(j)]); sum += c; cnt += (c > 0u) ? 1u : 0u; mine = (j == x) ? c : mine; }
        if (sum == G) break;
        __builtin_amdgcn_s_sleep(1);
        if ((++sp & 255u) == 0u) { if (xb_ld(&bar[XB_TMO])) break; if (sp > XB_SPIN_CAP) { atomicAdd(&bar[XB_TMO], 1u); break; } }
    }
    nloc = mine > 0u ? mine : 1u; nx = cnt > 0u ? cnt : 1u;
}

__device__ __forceinline__ void xcd_barrier(const XcdBarrier& b) {
    asm volatile("s_waitcnt vmcnt(0)" ::: "memory");
    __syncthreads();
    if (threadIdx.x == 0) {
        unsigned* bar = b.bar;
        __builtin_amdgcn_s_waitcnt(0);
        unsigned nloc = b.st[0], nx = b.st[1];
        if (nloc == 0u) { xcd_barrier_complete(bar, b.x, nloc, nx); b.st[0] = nloc; b.st[1] = nx; }
        const unsigned old = xb_add(&bar[XB_XSUB(b.x)], 1u);
        const unsigned gen = old / nloc;
        if (old + 1u == (gen + 1u) * nloc) {
            __builtin_amdgcn_fence(__ATOMIC_RELEASE, "agent");
            asm volatile("s_waitcnt vmcnt(0)" ::: "memory");
            const unsigned og = xb_add(&bar[XB_TOP], 1u);
            const unsigned tg = og / nx;
            if (og + 1u == (tg + 1u) * nx) xb_add(&bar[XB_TOPGEN], 1u);
            else XB_SPIN(xb_ld(&bar[XB_TOPGEN]) == tg, bar);
            __builtin_amdgcn_fence(__ATOMIC_ACQUIRE, "agent");
            xb_add(&bar[XB_XGEN(b.x)], 1u);
            asm volatile("s_waitcnt vmcnt(0)" ::: "memory");
        } else {
            XB_SPIN(xb_ld(&bar[XB_XGEN(b.x)]) == gen, bar);
            __builtin_amdgcn_fence(__ATOMIC_ACQUIRE, "agent");
            asm volatile("s_waitcnt vmcnt(0)" ::: "memory");
        }
    }
    __syncthreads();
}
__device__ __forceinline__ void postproj_row(const Ptrs& P, int l, int row, int lane) {
    bf16* zr = (bf16*)(P.ws + WS_Z) + (size_t)row * ZW;
    const v2u qw = *(const GAS v2u*)(zr + 4 * lane);
    const unsigned cw = *(const GAS unsigned*)(zr + 256 + 2 * lane);
    const v4u vw = *(const GAS v4u*)(zr + 1024 + 8 * lane);
    float kx1 = 0.f, kx2 = 0.f;
    if (lane < 16) { kx1 = bf2f(zr[384 + lane]); kx2 = bf2f(zr[400 + lane]); }
    const float q0 = bflo(qw.x), q1 = bfhi(qw.x), q2 = bflo(qw.y), q3 = bfhi(qw.y);
    const float c0 = bflo(cw), c1 = bfhi(cw);
    float vv[8] = {bflo(vw.x), bfhi(vw.x), bflo(vw.y), bfhi(vw.y), bflo(vw.z), bfhi(vw.z), bflo(vw.w), bfhi(vw.w)};
    float sq = (q0 * q0 + q1 * q1) + (q2 * q2 + q3 * q3), sc = c0 * c0 + c1 * c1, sv = 0.f;
#pragma unroll
    for (int e = 0; e < 8; ++e) sv += vv[e] * vv[e];
    sq = wave_sum(sq); sc = wave_sum(sc); sv = wave_sum(sv);
    const float rq = 1.0f / sqrtf(sq * (1.f / QL) + EPS), rc = 1.0f / sqrtf(sc * (1.f / KVL) + EPS), rv = 1.0f / sqrtf(sv * (1.f / GMW) + EPS);
    const bool samp = row >= MP; const int rs = row - MP;
    const int pos_idx = samp ? SEQ + (rs & 3) : (row & (SEQ - 1));
    { const f32x4 g = *(const f32x4*)(P.q_norm + l * QL + 4 * lane);
      v2u o; o.x = pk2(q0 * rq * g.x, q1 * rq * g.y); o.y = pk2(q2 * rq * g.z, q3 * rq * g.w); *(GAS v2u*)(zr + 4 * lane) = o; }
    { const f32x2 g = *(const f32x2*)(P.kv_norm + l * KVL + 2 * lane); const float a = c0 * rc * g.x, b = c1 * rc * g.y;
      *(GAS unsigned*)(zr + 256 + 2 * lane) = pk2(a, b);
      float* op = samp ? P.out + O_CKV_S + ((size_t)l * MS + rs) * KVL : P.out + O_CKV_P + ((size_t)l * MP + row) * KVL;
      *(GAS f32x2*)(op + 2 * lane) = (f32x2){a, b}; }
    if (lane < 16) { const f32x2 cs = *(const f32x2*)((const float*)(P.ws + WS_ROPE) + (size_t)pos_idx * 32 + 2 * lane);
      const float y1 = kx1 * cs.x - kx2 * cs.y, y2 = kx2 * cs.x + kx1 * cs.y;
      *(GAS unsigned*)(zr + 384 + 2 * lane) = pk2(y1, y2);
      float* op = samp ? P.out + O_KR_S + ((size_t)l * MS + rs) * ROPE : P.out + O_KR_P + ((size_t)l * MP + row) * ROPE;
      op[lane] = y1; op[16 + lane] = y2; }
    { const f32x4 g0 = *(const f32x4*)(P.v_norm + l * GMW + 8 * lane), g1 = *(const f32x4*)(P.v_norm + l * GMW + 8 * lane + 4);
      const float gg[8] = {g0.x, g0.y, g0.z, g0.w, g1.x, g1.y, g1.z, g1.w};
#pragma unroll
      for (int e = 0; e < 8; ++e) vv[e] = vv[e] * rv * gg[e];
      v4u o; o.x = pk2(vv[0], vv[1]); o.y = pk2(vv[2], vv[3]); o.z = pk2(vv[4], vv[5]); o.w = pk2(vv[6], vv[7]);
      *(GAS v4u*)(zr + 1024 + 8 * lane) = o;
      if (samp) { float* op = P.out + O_V_S + ((size_t)l * MS + rs) * GMW + 8 * lane;
        *(GAS f32x4*)op = (f32x4){vv[0], vv[1], vv[2], vv[3]}; *(GAS f32x4*)(op + 4) = (f32x4){vv[4], vv[5], vv[6], vv[7]}; } }
}

template <int NR>
__device__ __forceinline__ void postproj_rows_ck(const Ptrs& P, int l, const int (&rows)[NR], int lane) {
    unsigned cw[NR]; float kx1[NR], kx2[NR]; f32x2 cs[NR];
#pragma unroll
    for (int r = 0; r < NR; ++r) { if (rows[r] >= MP) continue; bf16* zr = (bf16*)(P.ws + WS_Z) + (size_t)rows[r] * ZW;
        cw[r] = *(const GAS unsigned*)(zr + 256 + 2 * lane); kx1[r] = 0.f; kx2[r] = 0.f; cs[r] = (f32x2){0.f, 0.f};
        if (lane < 16) { kx1[r] = bf2f(zr[384 + lane]); kx2[r] = bf2f(zr[400 + lane]); cs[r] = *(const f32x2*)((const float*)(P.ws + WS_ROPE) + (size_t)(rows[r] & (SEQ - 1)) * 32 + 2 * lane); } }
    const f32x2 g = *(const f32x2*)(P.kv_norm + l * KVL + 2 * lane);
#pragma unroll
    for (int r = 0; r < NR; ++r) { if (rows[r] >= MP) continue; bf16* zr = (bf16*)(P.ws + WS_Z) + (size_t)rows[r] * ZW;
        const float c0 = bflo(cw[r]), c1 = bfhi(cw[r]);
        const float rc = 1.0f / sqrtf(wave_sum(c0 * c0 + c1 * c1) * (1.f / KVL) + EPS);
        const float a = c0 * rc * g.x, b = c1 * rc * g.y;
        *(GAS unsigned*)(zr + 256 + 2 * lane) = pk2(a, b);
        *(GAS f32x2*)(P.out + O_CKV_P + ((size_t)l * MP + rows[r]) * KVL + 2 * lane) = (f32x2){a, b};
        if (lane < 16) { const float y1 = kx1[r] * cs[r].x - kx2[r] * cs[r].y, y2 = kx2[r] * cs[r].x + kx1[r] * cs[r].y;
            *(GAS unsigned*)(zr + 384 + 2 * lane) = pk2(y1, y2);
            float* op = P.out + O_KR_P + ((size_t)l * MP + rows[r]) * ROPE; op[lane] = y1; op[16 + lane] = y2; } }
}

struct RowIO { const float* xold; const bf16* xbold; const bf16* trow; const float* slab; float* xnew; bf16* xb; float* rs; };
template <int NR>
__device__ __forceinline__ void resid_rows(const RowIO (&io)[NR], const bool (&valid)[NR], const float* gpost, int lane) {
    float t[NR][16], x[NR][16];
#pragma unroll
    for (int r = 0; r < NR; ++r) if (valid[r]) {
#pragma unroll
        for (int jj = 0; jj < 2; ++jj) {
            const int c0 = jj * 512 + 8 * lane;
            if (io[r].trow) { const v4u w = __builtin_nontemporal_load((const GAS v4u*)(io[r].trow + c0));
                t[r][8 * jj + 0] = bflo(w.x); t[r][8 * jj + 1] = bfhi(w.x); t[r][8 * jj + 2] = bflo(w.y); t[r][8 * jj + 3] = bfhi(w.y);
                t[r][8 * jj + 4] = bflo(w.z); t[r][8 * jj + 5] = bfhi(w.z); t[r][8 * jj + 6] = bflo(w.w); t[r][8 * jj + 7] = bfhi(w.w);
            } else {
                f32x4 a = {0.f, 0.f, 0.f, 0.f}, b = {0.f, 0.f, 0.f, 0.f};
#pragma unroll
                for (int ks = 0; ks < 4; ++ks) { a += *(const GAS f32x4*)(io[r].slab + (size_t)ks * MS * DM + c0); b += *(const GAS f32x4*)(io[r].slab + (size_t)ks * MS * DM + c0 + 4); }
                t[r][8 * jj + 0] = a.x; t[r][8 * jj + 1] = a.y; t[r][8 * jj + 2] = a.z; t[r][8 * jj + 3] = a.w; t[r][8 * jj + 4] = b.x; t[r][8 * jj + 5] = b.y; t[r][8 * jj + 6] = b.z; t[r][8 * jj + 7] = b.w;
            }
            if (io[r].xold) { const f32x4 xa = __builtin_nontemporal_load((const GAS f32x4*)(io[r].xold + c0)), xb = __builtin_nontemporal_load((const GAS f32x4*)(io[r].xold + c0 + 4));
                x[r][8 * jj + 0] = xa.x; x[r][8 * jj + 1] = xa.y; x[r][8 * jj + 2] = xa.z; x[r][8 * jj + 3] = xa.w; x[r][8 * jj + 4] = xb.x; x[r][8 * jj + 5] = xb.y; x[r][8 * jj + 6] = xb.z; x[r][8 * jj + 7] = xb.w;
            } else { const v4u w = *(const GAS v4u*)(io[r].xbold + c0); const float inv = 1.0f / *(const GAS float*)io[r].rs;
                x[r][8 * jj + 0] = bflo(w.x) * inv; x[r][8 * jj + 1] = bfhi(w.x) * inv; x[r][8 * jj + 2] = bflo(w.y) * inv; x[r][8 * jj + 3] = bfhi(w.y) * inv;
                x[r][8 * jj + 4] = bflo(w.z) * inv; x[r][8 * jj + 5] = bfhi(w.z) * inv; x[r][8 * jj + 6] = bflo(w.w) * inv; x[r][8 * jj + 7] = bfhi(w.w) * inv; }
        }
    }
    float gp[16];
#pragma unroll
    for (int jj = 0; jj < 2; ++jj) { const int c0 = jj * 512 + 8 * lane;
        const f32x4 g0 = *(const f32x4*)(gpost + c0), g1 = *(const f32x4*)(gpost + c0 + 4); gp[8 * jj] = g0.x; gp[8 * jj + 1] = g0.y; gp[8 * jj + 2] = g0.z; gp[8 * jj + 3] = g0.w; gp[8 * jj + 4] = g1.x; gp[8 * jj + 5] = g1.y; gp[8 * jj + 6] = g1.z; gp[8 * jj + 7] = g1.w; }
#pragma unroll
    for (int r = 0; r < NR; ++r) if (valid[r]) {
        float s = 0.f;
#pragma unroll
        for (int e = 0; e < 16; ++e) s += t[r][e] * t[r][e];
        const float rstd = 1.0f / sqrtf(wave_sum(s) * (1.f / DM) + EPS);
        float s2 = 0.f;
#pragma unroll
        for (int e = 0; e < 16; ++e) { x[r][e] += t[r][e] * rstd * gp[e]; s2 += x[r][e] * x[r][e]; }
        if (io[r].xnew) {
#pragma unroll
            for (int jj = 0; jj < 2; ++jj) { const int c0 = jj * 512 + 8 * lane;
                __builtin_nontemporal_store((f32x4){x[r][8 * jj], x[r][8 * jj + 1], x[r][8 * jj + 2], x[r][8 * jj + 3]}, (GAS f32x4*)(io[r].xnew + c0));
                __builtin_nontemporal_store((f32x4){x[r][8 * jj + 4], x[r][8 * jj + 5], x[r][8 * jj + 6], x[r][8 * jj + 7]}, (GAS f32x4*)(io[r].xnew + c0 + 4)); } }
        if (io[r].xb) {
            const float r2 = 1.0f / sqrtf(wave_sum(s2) * (1.f / DM) + EPS);
            if (lane == 0) *io[r].rs = r2;
#pragma unroll
            for (int jj = 0; jj < 2; ++jj) { const int c0 = jj * 512 + 8 * lane;
                v4u o; o.x = pk2(x[r][8 * jj] * r2, x[r][8 * jj + 1] * r2); o.y = pk2(x[r][8 * jj + 2] * r2, x[r][8 * jj + 3] * r2); o.z = pk2(x[r][8 * jj + 4] * r2, x[r][8 * jj + 5] * r2); o.w = pk2(x[r][8 * jj + 6] * r2, x[r][8 * jj + 7] * r2);
                *(GAS v4u*)(io[r].xb + c0) = o; }
        }
    }
}

constexpr int AT_KSLOT = 12288, AT_VSLOT = 8192, AT_VOFF = 3 * AT_KSLOT, AT_LDS = AT_VOFF + 3 * AT_VSLOT;
__device__ __forceinline__ void glds16(const void* gsrc, unsigned lds_dst) { unsigned keep;
    asm volatile("s_mov_b32 %0, m0\n\ts_mov_b32 m0, %2\n\ts_nop 0\n\tglobal_load_lds_dwordx4 %1, off\n\ts_mov_b32 m0, %0" : "=&s"(keep) : "v"(gsrc), "s"(lds_dst) : "memory"); }
__device__ __forceinline__ float xhalf_max(float v) { auto rr = __builtin_amdgcn_permlane32_swap(__float_as_uint(v), __float_as_uint(v), false, false); return __builtin_fmaxf(__uint_as_float(rr[0]), __uint_as_float(rr[1])); }
__device__ __forceinline__ float xhalf_sum(float v) { auto rr = __builtin_amdgcn_permlane32_swap(__float_as_uint(v), __float_as_uint(v), false, false); return __uint_as_float(rr[0]) + __uint_as_float(rr[1]); }
typedef __attribute__((address_space(3))) const char* lds_cptr;
__device__ __forceinline__ void at_kload2(bf16x8* kf, lds_cptr kp, int j) { kf[2 * j] = *(const LAS bf16x8*)(kp + j * 2048); kf[2 * j + 1] = *(const LAS bf16x8*)(kp + j * 2048 + 512); }
__device__ __forceinline__ unsigned at_cvtpk(float lo, float hi) { typedef float f2 __attribute__((ext_vector_type(2))); typedef __bf16 b2 __attribute__((ext_vector_type(2))); f2 v = {lo, hi}; b2 b = __builtin_convertvector(v, b2); return __builtin_bit_cast(unsigned, b); }
#define AT_SBAR() __builtin_amdgcn_sched_barrier(0)
#define AT_WAIT_BAR(N) asm volatile("s_waitcnt vmcnt(" #N ") lgkmcnt(0)\n\ts_barrier" ::: "memory")
__device__ __forceinline__ void attn_unit(const Ptrs& P, int b, int h, int qb, LAS char* lds, int tid) {
    asm volatile("" : "+v"(tid));
    const int lane = tid & 63, wid = __builtin_amdgcn_readfirstlane(tid >> 6), r32 = lane & 31, hi = lane >> 5;
    const bf16* Qn = (const bf16*)(P.ws + WS_QN); const bf16* Qr = (const bf16*)(P.ws + WS_QR); const bf16* KV = (const bf16*)(P.ws + WS_KV); const bf16* Z = (const bf16*)(P.ws + WS_Z);
    bf16* AG = (bf16*)(P.ws + WS_AG);
    const size_t rowbase = (size_t)b * SEQ; const int q0 = qb * 256, qrel = wid * 32 + r32, qrow = q0 + qrel;
    const unsigned lds0 = (unsigned)(uintptr_t)lds;
    const bf16* ksrc1 = KV + (rowbase + lane) * 1024 + h * 64 + wid * 8;
    const bf16* ksrc2 = Z + (rowbase + lane) * ZW + 384 + (wid & 3) * 8;
    const bf16* vsrc = KV + (rowbase + 16 * (wid & 3) + (lane >> 2)) * 1024 + 512 + h * 64 + (wid >> 2) * 32 + (lane & 3) * 8;
    const unsigned kd1 = lds0 + wid * 1024, kd2 = lds0 + (8 + (wid & 3)) * 1024, vd = lds0 + AT_VOFF + wid * 1024;
#define DMA_K(t, slot) do { glds16(ksrc1 + (size_t)(t) * 64 * 1024, (unsigned)__builtin_amdgcn_readfirstlane(kd1 + (slot) * AT_KSLOT)); glds16(ksrc2 + (size_t)(t) * 64 * ZW, (unsigned)__builtin_amdgcn_readfirstlane(kd2 + (slot) * AT_KSLOT)); } while (0)
#define DMA_V(t, slot) glds16(vsrc + (size_t)(t) * 64 * 1024, (unsigned)__builtin_amdgcn_readfirstlane(vd + (slot) * AT_VSLOT))
    const lds_cptr kp0 = (lds_cptr)lds + hi * 1024 + r32 * 16;
    const lds_cptr vp0 = (lds_cptr)lds + AT_VOFF + ((lane >> 4) & 1) * 32 + (lane & 3) * 8 + (4 * hi + ((lane & 15) >> 2)) * 64;
    const int NT = (q0 + 256) / 64;
    bf16x8 qr[6];
#pragma unroll
    for (int s = 0; s < 4; ++s) qr[s] = *(const GAS bf16x8*)(Qn + (rowbase + qrow) * 512 + h * 64 + 16 * s + 8 * hi);
#pragma unroll
    for (int s = 0; s < 2; ++s) qr[4 + s] = *(const GAS bf16x8*)(Qr + (rowbase + qrow) * 256 + h * 32 + 16 * s + 8 * hi);
    asm volatile("s_waitcnt vmcnt(0)" : "+v"(qr[0]), "+v"(qr[1]), "+v"(qr[2]), "+v"(qr[3]), "+v"(qr[4]), "+v"(qr[5]) :: "memory");
    DMA_K(0, 0); DMA_V(0, 0); DMA_K(1, 1); DMA_K(2, 2);
    float mhat = 0.f, l_reg = 0.f; f32x16 o0 = {}, o1 = {};
    bf16x8 kf[12];
#define CMASK(C0, C1, tt) do { const int jb_ = (tt) - (NT - 4); if (jb_ >= 0) { const int kb_ = 64 * jb_ + 4 * hi; \
        _Pragma("unroll") for (int r = 0; r < 16; ++r) { const int kv = kb_ + (r & 3) + 8 * (r >> 2); if (kv > qrel) C0[r] = -INFINITY; if (kv + 32 > qrel) C1[r] = -INFINITY; } } } while (0)
#define ROWMAX(C0, C1, out) do { float a_ = __builtin_fmaxf(__builtin_fmaxf(C0[0], C0[1]), C1[0]), b_ = __builtin_fmaxf(__builtin_fmaxf(C0[2], C0[3]), C1[1]); a_ = __builtin_fmaxf(__builtin_fmaxf(a_, C1[2]), C1[3]); \
        _Pragma("unroll") for (int r = 4; r < 16; r += 4) { a_ = __builtin_fmaxf(__builtin_fmaxf(a_, C0[r]), C0[r + 1]); b_ = __builtin_fmaxf(__builtin_fmaxf(b_, C0[r + 2]), C0[r + 3]); \
            a_ = __builtin_fmaxf(__builtin_fmaxf(a_, C1[r]), C1[r + 1]); b_ = __builtin_fmaxf(__builtin_fmaxf(b_, C1[r + 2]), C1[r + 3]); } \
        out = xhalf_max(__builtin_fmaxf(a_, b_)); } while (0)
    f32x16 pA0, pA1, pB0, pB1;
    AT_WAIT_BAR(5);
    {
#pragma unroll
        for (int j = 0; j < 6; ++j) at_kload2(kf, kp0, j);
        pA0 = __builtin_amdgcn_mfma_f32_32x32x16_bf16(kf[0], qr[0], (f32x16){}, 0, 0, 0); pA1 = __builtin_amdgcn_mfma_f32_32x32x16_bf16(kf[1], qr[0], (f32x16){}, 0, 0, 0);
#pragma unroll
        for (int s = 1; s < 6; ++s) { pA0 = __builtin_amdgcn_mfma_f32_32x32x16_bf16(kf[2 * s], qr[s], pA0, 0, 0, 0); pA1 = __builtin_amdgcn_mfma_f32_32x32x16_bf16(kf[2 * s + 1], qr[s], pA1, 0, 0, 0); }
        CMASK(pA0, pA1, 0);
        float rm; ROWMAX(pA0, pA1, rm); mhat = rm;
#pragma unroll
        for (int r = 0; r < 16; ++r) { pA0[r] = __builtin_amdgcn_exp2f(pA0[r] - mhat); pA1[r] = __builtin_amdgcn_exp2f(pA1[r] - mhat); }
    }
    AT_WAIT_BAR(0);
    DMA_K(3, 0); DMA_V(1, 1);
#pragma unroll
    for (int j = 0; j < 6; ++j) at_kload2(kf, kp0 + AT_KSLOT, j);
    AT_WAIT_BAR(3);
    s16x4 vlo[8], vhi[8]; v4u pw0, pw1, pw2, pw3;
    bool resc = false; float fsc = 1.f;
#define PKW(Pt, B) at_cvtpk(Pt[B], Pt[B + 1])
#define PAF(k) __builtin_bit_cast(bf16x8, pw##k)
#define VFR(i) cat8(vlo[i], vhi[i])
#define PIN(x) asm volatile("" : "+v"(x))
#define VRD(i) do { vlo[i] = vtr(vp_ + (((i) >> 2) * 4096 + ((i) & 3) * 1024)); vhi[i] = vtr(vp_ + (((i) >> 2) * 4096 + ((i) & 3) * 1024 + 512)); } while (0)
#define GAPA(MF, A0, A1, A2, A3, W0, W1, PW) do { MF; sacc += A0; sacc += A1; sacc += A2; sacc += A3; PIN(sacc); W0; W1; PIN(PW); AT_SBAR(); } while (0)
#define EXM(v) __builtin_amdgcn_exp2f((v) - mhat)
#define GAPB(MF, X, B) do { MF; X[B] = EXM(X[B]); X[B + 1] = EXM(X[B + 1]); X[B + 2] = EXM(X[B + 2]); X[B + 3] = EXM(X[B + 3]); PIN(X); AT_SBAR(); } while (0)
#define KRD(G, j) do { if (G) { at_kload2(kf, kp0 + sl_next * AT_KSLOT, j); AT_SBAR(); } } while (0)
#define STEP(C0, C1, P0, P1, t, GK, GV, GL) do { AT_SBAR(); \
        const lds_cptr vp_ = vp0 + sl_prev * AT_VSLOT; \
        VRD(0); AT_SBAR(); float sacc = (P0[0] + P0[1]); \
        GAPA(C0 = __builtin_amdgcn_mfma_f32_32x32x16_bf16(kf[0], qr[0], (f32x16){}, 0, 0, 0), P0[2], P0[3], P0[4], P0[5],     pw0[0] = PKW(P0, 0), pw0[1] = PKW(P0, 2), pw0); \
        VRD(4); AT_SBAR(); GAPA(C1 = __builtin_amdgcn_mfma_f32_32x32x16_bf16(kf[1], qr[0], (f32x16){}, 0, 0, 0), P0[6], P0[7], P0[8], P0[9],     pw0[2] = PKW(P0, 4), pw0[3] = PKW(P0, 6), pw0); \
        VRD(1); AT_SBAR(); GAPA(C0 = __builtin_amdgcn_mfma_f32_32x32x16_bf16(kf[2], qr[1], C0, 0, 0, 0),   P0[10], P0[11], P0[12], P0[13], pw1[0] = PKW(P0, 8), pw1[1] = PKW(P0, 10), pw1); \
        VRD(5); AT_SBAR(); GAPA(C1 = __builtin_amdgcn_mfma_f32_32x32x16_bf16(kf[3], qr[1], C1, 0, 0, 0),   P0[14], P0[15], P1[0], P1[1],   pw1[2] = PKW(P0, 12), pw1[3] = PKW(P0, 14), pw1); \
        VRD(2); AT_SBAR(); GAPA(C0 = __builtin_amdgcn_mfma_f32_32x32x16_bf16(kf[4], qr[2], C0, 0, 0, 0),   P1[2], P1[3], P1[4], P1[5],     pw2[0] = PKW(P1, 0), pw2[1] = PKW(P1, 2), pw2); \
        VRD(6); AT_SBAR(); GAPA(C1 = __builtin_amdgcn_mfma_f32_32x32x16_bf16(kf[5], qr[2], C1, 0, 0, 0),   P1[6], P1[7], P1[8], P1[9],     pw2[2] = PKW(P1, 4), pw2[3] = PKW(P1, 6), pw2); \
        VRD(3); AT_SBAR(); GAPA(C0 = __builtin_amdgcn_mfma_f32_32x32x16_bf16(kf[6], qr[3], C0, 0, 0, 0),   P1[10], P1[11], P1[12], P1[13], pw3[0] = PKW(P1, 8), pw3[1] = PKW(P1, 10), pw3); \
        VRD(7); AT_SBAR(); GAPA(C1 = __builtin_amdgcn_mfma_f32_32x32x16_bf16(kf[7], qr[3], C1, 0, 0, 0),   P1[14], P1[15], 0.f, 0.f,       pw3[2] = PKW(P1, 12), pw3[3] = PKW(P1, 14), pw3); \
        C0 = __builtin_amdgcn_mfma_f32_32x32x16_bf16(kf[8], qr[4], C0, 0, 0, 0); C1 = __builtin_amdgcn_mfma_f32_32x32x16_bf16(kf[9], qr[4], C1, 0, 0, 0); \
        C0 = __builtin_amdgcn_mfma_f32_32x32x16_bf16(kf[10], qr[5], C0, 0, 0, 0); C1 = __builtin_amdgcn_mfma_f32_32x32x16_bf16(kf[11], qr[5], C1, 0, 0, 0); \
        l_reg += sacc; \
        if (GK) { DMA_K((t) + 3, sl_cur); } if (GV) { DMA_V((t) + 1, sl_next); } \
        CMASK(C0, C1, t); \
        { float rm; ROWMAX(C0, C1, rm); resc = false; \
          if (__builtin_expect(__any(rm - mhat > 8.0f), 0)) { const float nm = __builtin_fmaxf(rm, mhat); fsc = __builtin_amdgcn_exp2f(mhat - nm); mhat = nm; l_reg *= fsc; resc = true; } } \
        AT_SBAR(); \
        GAPB(o0 = __builtin_amdgcn_mfma_f32_32x32x16_bf16(VFR(0), PAF(0), o0, 0, 0, 0), C0, 0); \
        GAPB(o1 = __builtin_amdgcn_mfma_f32_32x32x16_bf16(VFR(4), PAF(0), o1, 0, 0, 0), C0, 4); \
        KRD(GL, 0); GAPB(o0 = __builtin_amdgcn_mfma_f32_32x32x16_bf16(VFR(1), PAF(1), o0, 0, 0, 0), C0, 8); \
        KRD(GL, 1); GAPB(o1 = __builtin_amdgcn_mfma_f32_32x32x16_bf16(VFR(5), PAF(1), o1, 0, 0, 0), C0, 12); \
        KRD(GL, 2); GAPB(o0 = __builtin_amdgcn_mfma_f32_32x32x16_bf16(VFR(2), PAF(2), o0, 0, 0, 0), C1, 0); \
        KRD(GL, 3); GAPB(o1 = __builtin_amdgcn_mfma_f32_32x32x16_bf16(VFR(6), PAF(2), o1, 0, 0, 0), C1, 4); \
        KRD(GL, 4); GAPB(o0 = __builtin_amdgcn_mfma_f32_32x32x16_bf16(VFR(3), PAF(3), o0, 0, 0, 0), C1, 8); \
        KRD(GL, 5); GAPB(o1 = __builtin_amdgcn_mfma_f32_32x32x16_bf16(VFR(7), PAF(3), o1, 0, 0, 0), C1, 12); \
    } while (0)
#define RESC() do { if (resc) { _Pragma("unroll") for (int r = 0; r < 16; ++r) { o0[r] *= fsc; o1[r] *= fsc; } } } while (0)
    int sl_prev = 0, sl_cur = 1, sl_next = 2;
#define ROT() do { sl_prev = sl_cur; sl_cur = sl_next; sl_next = (sl_next == 2) ? 0 : sl_next + 1; } while (0)
#define ENDW(tt) do { if ((tt) + 3 < NT) { AT_WAIT_BAR(3); } else if ((tt) + 2 < NT) { AT_WAIT_BAR(1); } else { AT_WAIT_BAR(0); } } while (0)
    int t = 1;
    for (; t + 1 < NT; t += 2) {
        STEP(pB0, pB1, pA0, pA1, t, (t + 3 < NT), (t + 1 < NT), (t + 1 < NT));         ENDW(t);     RESC(); ROT();
        STEP(pA0, pA1, pB0, pB1, t + 1, (t + 4 < NT), (t + 2 < NT), (t + 2 < NT));     ENDW(t + 1); RESC(); ROT();
    }
    STEP(pB0, pB1, pA0, pA1, NT - 1, false, false, false); RESC();
    { float sacc = 0.f;
#pragma unroll
      for (int r = 0; r < 16; ++r) sacc += pB0[r] + pB1[r];
      l_reg += sacc;
      const lds_cptr vp_ = vp0 + sl_cur * AT_VSLOT;
#pragma unroll
      for (int ks = 0; ks < 4; ++ks) { const f32x16& pp = (ks >> 1) ? pB1 : pB0; const int s2 = ks & 1;
          const bf16x8 pf = pack8(pp[8 * s2], pp[8 * s2 + 1], pp[8 * s2 + 2], pp[8 * s2 + 3], pp[8 * s2 + 4], pp[8 * s2 + 5], pp[8 * s2 + 6], pp[8 * s2 + 7]);
          const lds_cptr vb = vp_ + ks * 1024;
          const bf16x8 v0 = cat8(vtr(vb), vtr(vb + 512)), v1 = cat8(vtr(vb + 4096), vtr(vb + 4096 + 512));
          o0 = __builtin_amdgcn_mfma_f32_32x32x16_bf16(v0, pf, o0, 0, 0, 0); o1 = __builtin_amdgcn_mfma_f32_32x32x16_bf16(v1, pf, o1, 0, 0, 0); } }
#undef DMA_K
#undef DMA_V
#undef CMASK
#undef ROWMAX
#undef PKW
#undef PAF
#undef VFR
#undef PIN
#undef VRD
#undef GAPA
#undef EXM
#undef GAPB
#undef KRD
#undef STEP
#undef RESC
#undef ROT
#undef ENDW
    l_reg = xhalf_sum(l_reg);
    const float rl = 1.0f / l_reg;
    bf16* orow = AG + (rowbase + qrow) * 1024 + h * 64;
#pragma unroll
    for (int q = 0; q < 4; ++q) { v2u w; w.x = pk2(o0[4 * q] * rl, o0[4 * q + 1] * rl); w.y = pk2(o0[4 * q + 2] * rl, o0[4 * q + 3] * rl); *(GAS v2u*)(orow + 8 * q + 4 * hi) = w;
        v2u w1; w1.x = pk2(o1[4 * q] * rl, o1[4 * q + 1] * rl); w1.y = pk2(o1[4 * q + 2] * rl, o1[4 * q + 3] * rl); *(GAS v2u*)(orow + 32 + 8 * q + 4 * hi) = w1; }
    asm volatile("s_waitcnt lgkmcnt(0)\n\ts_barrier" ::: "memory");
}

constexpr int MG_SLOT = 24576, MG_BOFF = 16384;
template <class Epi>
__device__ __forceinline__ void mid_gemm(const bf16* A, int lda, const bf16* Bt, int ldb, int Kper, int ntn, int KS, const Epi& E, int bx, int G, LAS char* lds, int tid) {
    asm volatile("" : "+v"(tid));
    const int lane = tid & 63, wid = __builtin_amdgcn_readfirstlane(tid >> 6), r32 = lane & 31, hi = lane >> 5, mb = wid & 3, nb = wid >> 2;
    const unsigned lds0 = (unsigned)(uintptr_t)lds;
    const int nitem = 4 * ntn * KS, nk = Kper / 64;
    for (int item = bx; item < nitem; item += G) {
        const int tm = item & 3, rest = item >> 2, tn = rest % ntn, ks = rest / ntn;
        const bf16* a0 = A + (size_t)(tm * 128 + (wid & 1) * 64 + lane) * lda + ks * Kper + (wid >> 1) * 8;
        const bf16* a1 = a0 + 32;
        const bf16* b0 = Bt + (size_t)(tn * 64 + lane) * ldb + ks * Kper + wid * 8;
        const unsigned da0 = lds0 + (wid >> 1) * 2048 + (wid & 1) * 1024, da1 = da0 + 4 * 2048, db0 = lds0 + MG_BOFF + wid * 1024;
#define MG_ISSUE(t, so) do { glds16(a0 + (t) * 64, (unsigned)__builtin_amdgcn_readfirstlane(da0 + (so))); glds16(a1 + (t) * 64, (unsigned)__builtin_amdgcn_readfirstlane(da1 + (so))); \
                             glds16(b0 + (t) * 64, (unsigned)__builtin_amdgcn_readfirstlane(db0 + (so))); } while (0)
        __syncthreads();
        MG_ISSUE(0, 0); if (nk > 1) MG_ISSUE(1, MG_SLOT);
        f32x16 acc = {}, acc2 = {};
        const LAS char* ap = lds + hi * 2048 + (mb * 32 + r32) * 16;
        const LAS char* bp = lds + MG_BOFF + hi * 1024 + (nb * 32 + r32) * 16;
        int sc = 0, s2 = 2 * MG_SLOT;
        for (int t = 0; t < nk; ++t) {
            if (t + 1 < nk) asm volatile("s_waitcnt vmcnt(3)\n\ts_barrier" ::: "memory"); else asm volatile("s_waitcnt vmcnt(0)\n\ts_barrier" ::: "memory");
            if (t + 2 < nk) MG_ISSUE(t + 2, s2);
#pragma unroll
            for (int s = 0; s < 4; ++s) { const bf16x8 af = *(const LAS bf16x8*)(ap + sc + s * 4096), bfr = *(const LAS bf16x8*)(bp + sc + s * 2048);
                if (s & 1) acc2 = __builtin_amdgcn_mfma_f32_32x32x16_bf16(bfr, af, acc2, 0, 0, 0); else acc = __builtin_amdgcn_mfma_f32_32x32x16_bf16(bfr, af, acc, 0, 0, 0); }
            sc = (sc == 2 * MG_SLOT) ? 0 : sc + MG_SLOT; s2 = (s2 == 2 * MG_SLOT) ? 0 : s2 + MG_SLOT;
        }
#undef MG_ISSUE
        acc += acc2;
        E(acc, tm * 128 + mb * 32 + r32, tn * 64 + nb * 32, ks, hi);
        asm volatile("s_waitcnt lgkmcnt(0)\n\ts_barrier" ::: "memory");
    }
}

constexpr int G_PITCH = 528;
__device__ __forceinline__ void gate_unit(const Ptrs& P, int l, int chunk, LAS char* lds, int tid) {
    asm volatile("" : "+v"(tid));
    const int lane = tid & 63, wid = __builtin_amdgcn_readfirstlane(tid >> 6), r32 = lane & 31, hi = lane >> 5;
    const bf16* Z = (const bf16*)(P.ws + WS_Z); bf16* AG = (bf16*)(P.ws + WS_AG);
    const bf16* Wsp = (const bf16*)(P.ws + WS_WL + (size_t)l * WL_STRIDE + WL_WSP);
    const size_t row0 = (size_t)chunk * CHUNK;
    const int iblk = wid >> 1, dblk = wid & 1, nsteps = 2 * (iblk + 1);
    const size_t irow = row0 + iblk * 32 + r32;
    for (int pass = 0; pass < 2; ++pass) {
        __syncthreads();
#pragma unroll
        for (int i = 0; i < 8; ++i) { const int c = tid + 512 * i, j = c >> 5, ch = c & 31; const v4u vv = *(const GAS v4u*)(Z + (row0 + j) * ZW + 1024 + pass * 256 + ch * 8);
            const float* sp = (const float*)(P.ws + WS_SSV) + (row0 + j) * 8; const f32x4 s0 = *(const GAS f32x4*)sp, s1 = *(const GAS f32x4*)(sp + 4);
            const float rv = 1.0f / sqrtf((((s0.x + s0.y) + (s0.z + s0.w)) + ((s1.x + s1.y) + (s1.z + s1.w))) * (1.f / GMW) + EPS);
            const float* gp = P.v_norm + l * GMW + pass * 256 + ch * 8; const f32x4 g0 = *(const f32x4*)gp, g1 = *(const f32x4*)(gp + 4);
            v4u o; o.x = pk2(bflo(vv.x) * rv * g0.x, bfhi(vv.x) * rv * g0.y); o.y = pk2(bflo(vv.y) * rv * g0.z, bfhi(vv.y) * rv * g0.w);
            o.z = pk2(bflo(vv.z) * rv * g1.x, bfhi(vv.z) * rv * g1.y); o.w = pk2(bflo(vv.w) * rv * g1.z, bfhi(vv.w) * rv * g1.w);
            *(LAS v4u*)(lds + j * G_PITCH + ch * 16) = o; }
        __syncthreads();
        bf16x8 a[8], an[8]; v2u uu[4], un[4]; float bsv, bsn;
#define G_LOAD(A_, U_, B_, g_) do { _Pragma("unroll") for (int s = 0; s < 8; ++s) A_[s] = *(const GAS bf16x8*)(Wsp + ((size_t)(g_) * 128 + iblk * 32 + r32) * 128 + 16 * s + 8 * hi); \
            B_ = P.b_sp[((size_t)l * 8 + (g_)) * 128 + iblk * 32 + r32]; \
            _Pragma("unroll") for (int q = 0; q < 4; ++q) U_[q] = *(const GAS v2u*)(Z + irow * ZW + 512 + (g_) * 64 + dblk * 32 + 8 * q + 4 * hi); } while (0)
        G_LOAD(a, uu, bsv, pass * 4);
#pragma unroll
        for (int gg = 0; gg < 4; ++gg) {
            const int g = pass * 4 + gg;
            if (gg < 3) G_LOAD(an, un, bsn, g + 1);
            f32x16 acc = {};
            const LAS char* vb0 = lds + (8 * hi + ((lane & 15) >> 2)) * G_PITCH + (gg * 64 + dblk * 32 + 16 * ((lane >> 4) & 1) + 4 * (lane & 3)) * 2;
#pragma unroll
            for (int s = 0; s < 8; ++s) if (s < nsteps) {
                const LAS char* vb = vb0 + 16 * s * G_PITCH;
                const bf16x8 bb = cat8(vtr(vb), vtr(vb + 4 * G_PITCH));
                acc = __builtin_amdgcn_mfma_f32_32x32x16_bf16(bb, a[s], acc, 0, 0, 0);
            }
            bf16* op = AG + irow * 1024 + 512 + g * 64 + dblk * 32 + 4 * hi;
#pragma unroll
            for (int q = 0; q < 4; ++q) { const float u0 = bflo(uu[q].x), u1 = bfhi(uu[q].x), u2 = bflo(uu[q].y), u3 = bfhi(uu[q].y);
                v2u w; w.x = pk2(u0 * (acc[4 * q] + bsv), u1 * (acc[4 * q + 1] + bsv)); w.y = pk2(u2 * (acc[4 * q + 2] + bsv), u3 * (acc[4 * q + 3] + bsv));
                *(GAS v2u*)(op + 8 * q) = w; }
            if (gg < 3) {
#pragma unroll
                for (int s = 0; s < 8; ++s) a[s] = an[s];
#pragma unroll
                for (int q = 0; q < 4; ++q) uu[q] = un[q];
                bsv = bsn; }
        }
#undef G_LOAD
    }
    __syncthreads();
}

constexpr int SV_PITCH = 336, SV_WAVE = 32 * SV_PITCH, SQ_BYTES = 10240;
#define SGLD(dst, ptr, off) asm volatile("global_load_dwordx4 %0, %1, off offset:" #off " nt" : "=&v"(dst) : "v"(ptr) : "memory")
__device__ __forceinline__ void sample_unit(const Ptrs& P, int l, int b, LAS char* lds, int tid) {
    asm volatile("" : "+v"(tid));
    const int lane = tid & 63, wid = __builtin_amdgcn_readfirstlane(tid >> 6), r32 = lane & 31, hi = lane >> 5;
    const bf16* Qs = (const bf16*)(P.ws + WS_QS); const bf16* Z = (const bf16*)(P.ws + WS_Z); bf16* AG = (bf16*)(P.ws + WS_AG);
    __syncthreads();
    for (int idx = tid; idx < 640; idx += 512) { const int s = idx >> 6, ln = idx & 63, q = ln & 31, h8 = ln >> 5; const int qt = q >> 3, qh = q & 7;
        const bf16* src = Qs + ((size_t)b * 4 + qt) * 1280 + (s < 8 ? qh * 128 + 16 * s : 1024 + qh * 32 + 16 * (s - 8)) + 8 * h8;
        *(LAS v4u*)(lds + idx * 16) = *(const GAS v4u*)src; }
    const int qt = r32 >> 3;
    f32x16 o[4];
#pragma unroll
    for (int cb = 0; cb < 4; ++cb) o[cb] = (f32x16){};
    float mrun = -1e30f, lrun = 0.f;
    LAS char* vimg = lds + SQ_BYTES + wid * SV_WAVE;
    const float* cc = P.cache_c + (size_t)l * NPHYS * PAGE * KVL; const float* cr = P.cache_r + (size_t)l * NPHYS * PAGE * ROPE;
    const int pgv = P.ptab[b * NPAGES + lane];
    __syncthreads();
    const int ntile = 32 + (wid == 0 ? 1 : 0);
    f32x4 raw[20];
#define S_ISSUE(it_) do { const int it__ = (it_); \
        if (it__ < 32) { const int ph0 = __shfl(pgv, 2 * it__), ph1 = __shfl(pgv, 2 * it__ + 1); \
            const float* kc0 = cc + ((size_t)ph0 * PAGE + 16 * wid + (lane >> 5)) * KVL + (lane & 31) * 4; const float* kc1 = cc + ((size_t)ph1 * PAGE + 16 * wid + (lane >> 5)) * KVL + (lane & 31) * 4; \
            const float* kr0 = cr + ((size_t)ph0 * PAGE + 16 * wid + (lane >> 3)) * ROPE + (lane & 7) * 4; const float* kr1 = cr + ((size_t)ph1 * PAGE + 16 * wid + (lane >> 3)) * ROPE + (lane & 7) * 4; \
            _Pragma("unroll") for (int j = 0; j < 8; ++j) { const float* pp = kc0 + (size_t)(2 * j) * KVL; SGLD(raw[j], pp, 0); } \
            _Pragma("unroll") for (int j = 0; j < 8; ++j) { const float* pp = kc1 + (size_t)(2 * j) * KVL; SGLD(raw[8 + j], pp, 0); } \
            _Pragma("unroll") for (int j = 0; j < 2; ++j) { const float* pp = kr0 + (size_t)(8 * j) * ROPE; SGLD(raw[16 + j], pp, 0); } \
            _Pragma("unroll") for (int j = 0; j < 2; ++j) { const float* pp = kr1 + (size_t)(8 * j) * ROPE; SGLD(raw[18 + j], pp, 0); } \
        } else { const float* kc = P.out + O_CKV_S + ((size_t)l * MS + b * 4) * KVL + (lane & 31) * 4; const float* kr = P.out + O_KR_S + ((size_t)l * MS + b * 4) * ROPE + (lane & 7) * 4; \
            _Pragma("unroll") for (int j = 0; j < 16; ++j) { const float* pp = kc + (size_t)((2 * j + (lane >> 5)) & 3) * KVL; SGLD(raw[j], pp, 0); } \
            _Pragma("unroll") for (int j = 0; j < 4; ++j) { const float* pp = kr + (size_t)((8 * j + (lane >> 3)) & 3) * ROPE; SGLD(raw[16 + j], pp, 0); } } } while (0)
    S_ISSUE(0);
    for (int it = 0; it < ntile; ++it) {
        asm volatile("s_waitcnt vmcnt(0)" : "+v"(raw[0]), "+v"(raw[1]), "+v"(raw[2]), "+v"(raw[3]), "+v"(raw[4]), "+v"(raw[5]), "+v"(raw[6]), "+v"(raw[7]), "+v"(raw[8]), "+v"(raw[9]),
                     "+v"(raw[10]), "+v"(raw[11]), "+v"(raw[12]), "+v"(raw[13]), "+v"(raw[14]), "+v"(raw[15]), "+v"(raw[16]), "+v"(raw[17]), "+v"(raw[18]), "+v"(raw[19]) :: "memory");
#pragma unroll
        for (int j = 0; j < 16; ++j) { v2u w; w.x = pg8::cvt_pk_bf16(raw[j].x, raw[j].y); w.y = pg8::cvt_pk_bf16(raw[j].z, raw[j].w); *(LAS v2u*)(vimg + (2 * j + (lane >> 5)) * SV_PITCH + (lane & 31) * 8) = w; }
#pragma unroll
        for (int j = 0; j < 4; ++j) { v2u w; w.x = pg8::cvt_pk_bf16(raw[16 + j].x, raw[16 + j].y); w.y = pg8::cvt_pk_bf16(raw[16 + j].z, raw[16 + j].w); *(LAS v2u*)(vimg + (8 * j + (lane >> 3)) * SV_PITCH + 256 + (lane & 7) * 8) = w; }
        const bool newt = it >= 32;
        if (it + 1 < ntile) S_ISSUE(it + 1);
        LDS_WAIT();
        f32x16 p = {};
#pragma unroll 2
        for (int s = 0; s < 10; ++s) { const bf16x8 kf = *(const LAS bf16x8*)(vimg + r32 * SV_PITCH + (16 * s + 8 * hi) * 2), qf = *(const LAS bf16x8*)(lds + (s * 64 + lane) * 16);
            p = __builtin_amdgcn_mfma_f32_32x32x16_bf16(kf, qf, p, 0, 0, 0); }
        if (newt) {
#pragma unroll
            for (int r = 0; r < 16; ++r) { const int key = crow(r, hi); if (key > qt) p[r] = -INFINITY; }
        }
        float mx = p[0];
#pragma unroll
        for (int r = 1; r < 16; ++r) mx = fmaxf(mx, p[r]);
        mx = fmaxf(mx, __shfl_xor(mx, 32));
        const float mnew = fmaxf(mrun, mx), alpha = __builtin_amdgcn_exp2f(mrun - mnew); mrun = mnew;
        float ps = 0.f;
#pragma unroll
        for (int r = 0; r < 16; ++r) { p[r] = __builtin_amdgcn_exp2f(p[r] - mnew); ps += p[r]; }
        lrun = lrun * alpha + ps;
#pragma unroll
        for (int cb = 0; cb < 4; ++cb)
#pragma unroll
            for (int r = 0; r < 16; ++r) o[cb][r] *= alpha;
        LDS_WAIT();
#pragma unroll
        for (int s2 = 0; s2 < 2; ++s2) {
            const bf16x8 pf = pack8(p[8 * s2], p[8 * s2 + 1], p[8 * s2 + 2], p[8 * s2 + 3], p[8 * s2 + 4], p[8 * s2 + 5], p[8 * s2 + 6], p[8 * s2 + 7]);
            const LAS char* vb = vimg + (16 * s2 + 4 * hi + ((lane & 15) >> 2)) * SV_PITCH + (16 * ((lane >> 4) & 1) + 4 * (lane & 3)) * 2;
#pragma unroll
            for (int cb = 0; cb < 4; ++cb) { const bf16x8 vf = cat8(vtr(vb + cb * 64), vtr(vb + cb * 64 + 8 * SV_PITCH)); o[cb] = __builtin_amdgcn_mfma_f32_32x32x16_bf16(vf, pf, o[cb], 0, 0, 0); }
        }
        LDS_WAIT();
    }
#undef S_ISSUE
    lrun += __shfl_xor(lrun, 32);
    __syncthreads();
    LAS float* ost = (LAS float*)lds; LAS float* mst = (LAS float*)(lds + 132096); LAS float* lst = mst + 256;
#pragma unroll
    for (int cb = 0; cb < 4; ++cb)
#pragma unroll
        for (int r = 0; r < 16; ++r) ost[(wid * 128 + cb * 32 + crow(r, hi)) * 32 + r32] = o[cb][r];
    if (hi == 0) { mst[wid * 32 + r32] = mrun; lst[wid * 32 + r32] = lrun; }
    __syncthreads();
    {
        const int q = tid >> 4, c0 = (tid & 15) * 8;
        float mm = mst[q];
#pragma unroll
        for (int w = 1; w < 8; ++w) mm = fmaxf(mm, mst[w * 32 + q]);
        float sc[8], lt = 0.f;
#pragma unroll
        for (int w = 0; w < 8; ++w) { sc[w] = __builtin_amdgcn_exp2f(mst[w * 32 + q] - mm); lt += lst[w * 32 + q] * sc[w]; }
        const float rl = 1.0f / lt;
        float ol[8];
#pragma unroll
        for (int e = 0; e < 8; ++e) { float a = 0.f;
#pragma unroll
            for (int w = 0; w < 8; ++w) a += ost[(w * 128 + c0 + e) * 32 + q] * sc[w];
            ol[e] = a * rl; }
        __syncthreads();
        LAS float* olat = (LAS float*)lds;
#pragma unroll
        for (int e = 0; e < 8; ++e) olat[q * 128 + c0 + e] = ol[e];
    }
    __syncthreads();
    {
        const LAS float* olat = (const LAS float*)lds;
        const int q = tid >> 4, v0 = (tid & 15) * 4, h = q & 7, t = q >> 3;
        const float* wv = P.w_uv + (size_t)l * KVL * 512 + h * 64 + v0;
        f32x4 a = {0.f, 0.f, 0.f, 0.f};
#pragma unroll 32
        for (int c = 0; c < 128; ++c) { const f32x4 w = *(const GAS f32x4*)(wv + (size_t)c * 512); a += w * olat[q * 128 + c]; }
        v2u w; w.x = pk2(a.x, a.y); w.y = pk2(a.z, a.w);
        *(GAS v2u*)(AG + ((size_t)MP + b * 4 + t) * 1024 + h * 64 + v0) = w;
    }
    {
        const int col = tid, g = col >> 6;
        float vn[4], uu[4];
#pragma unroll
        for (int t = 0; t < 4; ++t) { vn[t] = bf2f(Z[((size_t)MP + b * 4 + t) * ZW + 1024 + col]); uu[t] = bf2f(Z[((size_t)MP + b * 4 + t) * ZW + 512 + col]); }
        const float* ws = P.w_sp + ((size_t)l * 8 + g) * 128 * 128; const float* bs = P.b_sp + ((size_t)l * 8 + g) * 128;
#pragma unroll
        for (int t = 0; t < 4; ++t) { float a = bs[t];
#pragma unroll
            for (int j = 0; j <= t; ++j) a += ws[t * 128 + j] * vn[j];
            AG[((size_t)MP + b * 4 + t) * 1024 + 512 + col] = (bf16)f2bf(uu[t] * a); }
    }
    __syncthreads();
}
constexpr int NWAVES = 8;
#ifndef NO_SAMPLE
#define NO_SAMPLE 0
#endif
#ifndef NO_ATTN
#define NO_ATTN 0
#endif
#ifndef NO_GATE
#define NO_GATE 0
#endif
#ifndef QPER
#define QPER 4
#endif
#ifndef PH_MASK
#define PH_MASK 0x3ff
#endif
#define PHEN(k) (((PH_MASK) >> (k)) & 1)
#ifndef PH_DOUBLE
#define PH_DOUBLE 0
#endif
#define PHREP(k) (1 + (((PH_DOUBLE) >> (k)) & 1))
constexpr int N_PHASES = 1 + 9 * DEPTH;
struct Args { Ptrs p; int ph_lo, ph_hi, one_launch, pad; };

__global__ void __launch_bounds__(NWAVES * 64, 2) fwd(Args args) {
    extern __shared__ __attribute__((aligned(16))) unsigned char lds_raw[];
    LAS unsigned char* lds = (LAS unsigned char*)lds_raw;
    const Ptrs& P = args.p;
    const int tid = threadIdx.x;
    const int G = gridDim.x; const int bx = blockIdx.x; const int vcu = (G % 8 == 0) ? (bx % 8) * (G / 8) + bx / 8 : bx;
    const int NGW = G * NWAVES;
    gu32* ctl = (gu32*)(P.ws + WS_CTL);
    for (int u = tid; u < (LDS_BYTES - LDSCTL_OFF) / 4; u += NWAVES * 64) ((LAS unsigned*)(lds + LDSCTL_OFF))[u] = 0u;
    __syncthreads();
    XcdBarrier bar; bar.bar = (unsigned*)(ctl + CW_BAR); bar.x = 0; bar.st = nullptr;
    if (args.one_launch) bar = xcd_barrier_post((unsigned*)(ctl + CW_BAR), (volatile LAS unsigned*)(lds + MISC_OFF) + 8);
    const int lo = args.ph_lo, hi_ = args.ph_hi;
#define IN(k) (lo <= (k) && (k) < hi_)
#define SEAM(k) do { if (IN(k) && IN((k) + 1)) { xcd_barrier(bar); for (int rb_ = 1; rb_ < PHREP(14); ++rb_) xcd_barrier(bar); } } while (0)

    bf16* Hb = (bf16*)(P.ws + WS_H); bf16* Zb = (bf16*)(P.ws + WS_Z); bf16* AGb = (bf16*)(P.ws + WS_AG); bf16* MIXb = (bf16*)(P.ws + WS_MIX); bf16* Rb = (bf16*)(P.ws + WS_R);
    float* FSb = (float*)(P.ws + WS_FS); float* RSb = (float*)(P.ws + WS_RS);
    const float* ropet = (const float*)(P.ws + WS_ROPE);

    for (int rep_ = 0; rep_ < PHREP(0); ++rep_) if (PHEN(0) && IN(0)) {
            int ptid = threadIdx.x; asm volatile("" : "+v"(ptid)); const int lane = ptid & 63, wave = __builtin_amdgcn_readfirstlane(ptid >> 6), gw = vcu * NWAVES + wave; (void)lane; (void)gw;
        LAS float* scr = (LAS float*)(lds + RING_OFF + wave * 16384);
        constexpr int I_IN = (DM / 64) * (INW / 32), I_UQ = (QL / 64) * (768 / 32), I_UK = (KVL / 64) * (512 / 32), I_OUT = (DM / 64) * (DM / 32), I_UP = (DM / 64) * (DFF / 32), I_DN = (DFF / 64) * (DM / 32);
        constexpr int I_PAD = 96, I_QA = 1024, I_SP = 256;
        constexpr int PER_L = I_IN + I_UQ + 2 * I_UK + I_OUT + I_UP + I_DN + I_PAD + I_QA + I_SP;
        for (int it0 = gw; it0 < DEPTH * PER_L; it0 += NGW) {
            const int l = it0 / PER_L; int r = it0 - l * PER_L;
            unsigned char* wl = P.ws + WS_WL + (size_t)l * WL_STRIDE;
            if (r < I_IN) { p0_transpose_item<1>(P.w_in + (size_t)l * DM * INW, DM, INW, (bf16*)(wl + WL_WIN), 0, scr, r, lane, P.nm_pre + l * DM); continue; } r -= I_IN;
            if (r < I_UQ) { p0_transpose_item<2>(P.w_uq + (size_t)l * QL * 768, QL, 768, (bf16*)(wl + WL_WUQ), 0, scr, r, lane, P.q_norm + l * QL); continue; } r -= I_UQ;
            if (r < I_UK) { p0_transpose_item<0>(P.w_uk + (size_t)l * KVL * 512, KVL, 512, (bf16*)(wl + WL_WKV), 0, scr, r, lane); continue; } r -= I_UK;
            if (r < I_UK) { p0_transpose_item<0>(P.w_uv + (size_t)l * KVL * 512, KVL, 512, (bf16*)(wl + WL_WKV), 512, scr, r, lane); continue; } r -= I_UK;
            if (r < I_OUT) { p0_transpose_item<0>(P.w_out + (size_t)l * DM * DM, DM, DM, (bf16*)(wl + WL_WOUT), 0, scr, r, lane); continue; } r -= I_OUT;
            if (r < I_UP) { p0_transpose_item<0>(P.w_up + (size_t)l * DM * DFF, DM, DFF, (bf16*)(wl + WL_WUP), 0, scr, r, lane, P.nf_pre + l * DM); continue; } r -= I_UP;
            if (r < I_DN) { p0_transpose_item<0>(P.w_dn + (size_t)l * DFF * DM, DFF, DM, (bf16*)(wl + WL_WDN), 0, scr, r, lane); continue; } r -= I_DN;
            if (r < I_PAD) {
                bf16* d = (bf16*)(wl + WL_WIN) + (size_t)(416 + r) * DM;
#pragma unroll
                for (int j = 0; j < 2; ++j) *(GAS v4u*)(d + j * 512 + 8 * lane) = (v4u){0u, 0u, 0u, 0u};
                continue; } r -= I_PAD;
            if (r < I_QA) {
                const int h = r >> 7, c = r & 127; const float* uq = P.w_uq + (size_t)l * QL * 768 + h * 96; const float* uk = P.w_uk + (size_t)l * KVL * 512 + (size_t)c * 512 + h * 64;
                bf16* d = (bf16*)(wl + WL_WQS) + (size_t)r * QL;
#pragma unroll 1
                for (int m = 0; m < 4; ++m) { const int k = lane + 64 * m; float a = 0.f;
#pragma unroll 4
                    for (int n = 0; n < 64; n += 4) { const f32x4 x = *(const GAS f32x4*)(uq + (size_t)k * 768 + n), y = *(const GAS f32x4*)(uk + n); a += (x.x * y.x + x.y * y.y) + (x.z * y.z + x.w * y.w); }
                    d[k] = (bf16)f2bf(a); }
                continue; } r -= I_QA;
            {
                const size_t e0 = (size_t)r * 512 + 8 * lane; const float* src = P.w_sp + (size_t)l * 8 * 128 * 128 + e0; bf16* d = (bf16*)(wl + WL_WSP) + e0;
                const int i = (int)((e0 >> 7) & 127), j0 = (int)(e0 & 127);
                const f32x4 a = *(const GAS f32x4*)src, b2 = *(const GAS f32x4*)(src + 4); const float v[8] = {a.x, a.y, a.z, a.w, b2.x, b2.y, b2.z, b2.w};
                float m[8];
#pragma unroll
                for (int e = 0; e < 8; ++e) m[e] = (j0 + e <= i) ? v[e] : 0.f;
                v4u o; o.x = pk2(m[0], m[1]); o.y = pk2(m[2], m[3]); o.z = pk2(m[4], m[5]); o.w = pk2(m[6], m[7]); *(GAS v4u*)d = o;
            }
        }
        for (int e = gw * 64 + lane; e < NPOS * 16; e += NGW * 64) { const int pi = e >> 4, i = e & 15; const int pos = pi < SEQ ? pi : PAST + (pi - SEQ); float c, s; rope_entry(pos, i, c, s);
            *(GAS f32x2*)((float*)(P.ws + WS_ROPE) + (size_t)e * 2) = (f32x2){c, s}; }
        for (int m0 = gw; m0 < M; m0 += 4 * NGW) { const float* xr[4]; bf16* orow[4]; float* rsp[4]; bool valid[4];
#pragma unroll
            for (int r = 0; r < 4; ++r) { const int m = m0 + r * NGW; valid[r] = m < M; const int mm = valid[r] ? m : m0;
                xr[r] = mm < MP ? P.x_p + (size_t)mm * DM : P.x_s + (size_t)(mm - MP) * DM; orow[r] = Hb + (size_t)mm * DM; rsp[r] = RSb + mm; }
            rows_to_bf16_rs<4>(xr, orow, rsp, valid, lane); }
    }
    SEAM(0);

    for (int l = 0; l < DEPTH; ++l) {
        const int pb = 1 + 9 * l;
        unsigned char* wl = P.ws + WS_WL + (size_t)l * WL_STRIDE;
        for (int rep_ = 0; rep_ < PHREP(1); ++rep_) if (PHEN(1) && IN(pb + 0)) {
            int ptid = threadIdx.x; asm volatile("" : "+v"(ptid)); const int lane = ptid & 63, wave = __builtin_amdgcn_readfirstlane(ptid >> 6), gw = vcu * NWAVES + wave; (void)lane; (void)gw;
            { SEpiBf16<0> E{Zb + (size_t)MP * ZW, ZW, nullptr}; for (int r3 = 0; r3 < PHREP(13); ++r3) mid_gemm(Hb + (size_t)MP * DM, DM, (const bf16*)(wl + WL_WIN), DM, DM, ZW / 64, 1, E, bx, G, (LAS char*)lds, ptid); }
            __syncthreads();
            pg8::Gemm g{Hb, (const bf16*)(wl + WL_WIN), DM, DM, DM}; pg8::StaticOrder S; S.init(MP / 256, ZW / 256, G, bx);
            pg8::EpiZ E{Zb, ZW, (float*)(P.ws + WS_SSQ), (float*)(P.ws + WS_SSV)};
            pg8::gemm_phase<pg8::EpiZ, pg8::StaticOrder, true, true>(lds + RING_OFF, g, S, E, ptid);
        }
        SEAM(pb + 0);
        if (PHEN(2) && IN(pb + 1)) {
            int ptid = threadIdx.x; asm volatile("" : "+v"(ptid)); const int lane = ptid & 63, wave = __builtin_amdgcn_readfirstlane(ptid >> 6), gw = vcu * NWAVES + wave; (void)lane; (void)gw; for (int m = gw; m < MP; m += 4 * NGW) { const int rows[4] = {m, m + NGW, m + 2 * NGW, m + 3 * NGW}; postproj_rows_ck<4>(P, l, rows, lane); }
            for (int m = MP + gw; m < M; m += NGW) postproj_row(P, l, m, lane); }
        SEAM(pb + 1);
        for (int rep_ = 0; rep_ < PHREP(3); ++rep_) if (PHEN(3) && IN(pb + 2)) {
            int ptid = threadIdx.x; asm volatile("" : "+v"(ptid)); const int lane = ptid & 63, wave = __builtin_amdgcn_readfirstlane(ptid >> 6), gw = vcu * NWAVES + wave; (void)lane; (void)gw;
#ifndef NO_C1
            { SEpiQs E{(bf16*)(P.ws + WS_QS), ropet, C2}; for (int r3 = 0; r3 < PHREP(13); ++r3) mid_gemm(Zb + (size_t)MP * ZW, ZW, (const bf16*)(wl + WL_WQS), QL, QL, 1280 / 64, 1, E, bx, G, (LAS char*)lds, ptid); }
#endif
            __syncthreads();
#ifndef NO_C2
            { pg8::Gemm g{Zb, (const bf16*)(wl + WL_WUQ), ZW, QL, QL}; pg8::StaticOrder S; S.init(MP / 256, 3, G, bx);
              pg8::EpiQ E{(bf16*)(P.ws + WS_QN), (bf16*)(P.ws + WS_QR), ropet, C2, SEQ - 1, (const float*)(P.ws + WS_SSQ)};
              pg8::gemm_phase<pg8::EpiQ, pg8::StaticOrder, true, true>(lds + RING_OFF, g, S, E, ptid); }
#endif
            __syncthreads();
#ifndef NO_C3
            { pg8::Gemm g{Zb + 256, (const bf16*)(wl + WL_WKV), ZW, KVL, KVL}; pg8::StaticOrder S; S.init(MP / 256, 4, G, bx);
              pg8::EpiBf16<0> E{(bf16*)(P.ws + WS_KV), 1024, nullptr};
              int ptid2 = threadIdx.x; asm volatile("" : "+v"(ptid2));
              pg8::gemm_phase<pg8::EpiBf16<0>, pg8::StaticOrder, true, true>(lds + RING_OFF, g, S, E, ptid2); }
#endif
        }
        SEAM(pb + 2);
        for (int rep_ = 0; rep_ < PHREP(4); ++rep_) if (PHEN(4) && IN(pb + 3)) {
            int ptid = threadIdx.x; asm volatile("" : "+v"(ptid)); const int lane = ptid & 63, wave = __builtin_amdgcn_readfirstlane(ptid >> 6), gw = vcu * NWAVES + wave; (void)lane; (void)gw;
            volatile LAS unsigned* qslot = (volatile LAS unsigned*)(lds + MISC_OFF) + 16;
            gu32* qheads = ctl + CW_Q + 64 * 8 * (l * 2 + rep_);
            constexpr int NLOC = DB / 8 + NB * NH + MP / CHUNK / 8;
            const unsigned myx = xb_xcc_id() & 7u; unsigned kk = 0u;
            for (;;) {
                if (ptid == 0) { unsigned id = 0xffffffffu, xq = myx;
                    while (kk < 8u) { xq = (myx + kk) & 7u; id = __hip_atomic_fetch_add(qheads + 64 * xq, 1u, RLX_AGENT); if (id < (unsigned)NLOC) break; id = 0xffffffffu; ++kk; }
                    qslot[0] = id; qslot[1] = xq; }
                __syncthreads();
                const unsigned idu = qslot[0]; const int xq = (int)qslot[1];
                __syncthreads();
                if (idu == 0xffffffffu) break;
                const int idx = (int)idu;
                int ja = -1;
                if (idx < 64) { if ((idx & 3) == 0) { if (!NO_SAMPLE) sample_unit(P, l, 16 * xq + (idx >> 2), (LAS char*)lds, ptid); } else ja = (idx >> 2) * 3 + (idx & 3) - 1; }
                else if (idx < 80) ja = idx - 16;
                else if (idx < 112) { if (!NO_GATE) gate_unit(P, l, 32 * xq + (idx - 80), (LAS char*)lds, ptid); }
                else ja = idx - 48;
                if (ja >= 0) { if (!NO_ATTN) attn_unit(P, 2 * xq + ((ja & 15) >> 3), ja & 7, 7 - (ja >> 4), (LAS char*)lds, ptid); }
            }
            __syncthreads();
        }
        SEAM(pb + 3);
        for (int rep_ = 0; rep_ < PHREP(5); ++rep_) if (PHEN(5) && IN(pb + 4)) {
            int ptid = threadIdx.x; asm volatile("" : "+v"(ptid)); const int lane = ptid & 63, wave = __builtin_amdgcn_readfirstlane(ptid >> 6), gw = vcu * NWAVES + wave; (void)lane; (void)gw;
            { SEpiBf16<0> E{MIXb + (size_t)MP * DM, DM, nullptr}; for (int r3 = 0; r3 < PHREP(13); ++r3) mid_gemm(AGb + (size_t)MP * DM, DM, (const bf16*)(wl + WL_WOUT), DM, DM, DM / 64, 1, E, bx, G, (LAS char*)lds, ptid); }
            __syncthreads();
            pg8::Gemm g{AGb, (const bf16*)(wl + WL_WOUT), DM, DM, DM}; pg8::StaticOrder S; S.init(MP / 256, DM / 256, G, bx);
            pg8::EpiBf16<0> E{MIXb, DM, nullptr};
            pg8::gemm_phase<pg8::EpiBf16<0>, pg8::StaticOrder, true, true>(lds + RING_OFF, g, S, E, ptid);
        }
        SEAM(pb + 4);
        for (int rep_ = 0; rep_ < ((l == 0) ? PHREP(6) : 1); ++rep_) if (PHEN(6) && IN(pb + 5)) {
            int ptid = threadIdx.x; asm volatile("" : "+v"(ptid)); const int lane = ptid & 63, wave = __builtin_amdgcn_readfirstlane(ptid >> 6), gw = vcu * NWAVES + wave; (void)lane; (void)gw;
            for (int m0 = gw; m0 < M; m0 += 2 * NGW) { RowIO io[2]; bool valid[2];
#pragma unroll
                for (int r = 0; r < 2; ++r) { const int m = m0 + r * NGW; valid[r] = m < M; const int mm = valid[r] ? m : m0;
                    io[r].xold = (l == 0) ? (mm < MP ? P.x_p + (size_t)mm * DM : P.x_s + (size_t)(mm - MP) * DM) : nullptr; io[r].xbold = Hb + (size_t)mm * DM;
                    io[r].trow = MIXb + (size_t)mm * DM; io[r].slab = nullptr; io[r].xnew = nullptr; io[r].xb = Hb + (size_t)mm * DM; io[r].rs = RSb + mm; }
                resid_rows<2>(io, valid, P.nm_post + l * DM, lane); }
        }
        SEAM(pb + 5);
        for (int rep_ = 0; rep_ < PHREP(7); ++rep_) if (PHEN(7) && IN(pb + 6)) {
            int ptid = threadIdx.x; asm volatile("" : "+v"(ptid)); const int lane = ptid & 63, wave = __builtin_amdgcn_readfirstlane(ptid >> 6), gw = vcu * NWAVES + wave; (void)lane; (void)gw;
            { SEpiBf16<2> E{Rb + (size_t)MP * DFF, DFF, nullptr}; for (int r3 = 0; r3 < PHREP(13); ++r3) mid_gemm(Hb + (size_t)MP * DM, DM, (const bf16*)(wl + WL_WUP), DM, DM, DFF / 64, 1, E, bx, G, (LAS char*)lds, ptid); }
            __syncthreads();
            pg8::Gemm g{Hb, (const bf16*)(wl + WL_WUP), DM, DM, DM}; pg8::StaticOrder S; S.init(MP / 256, DFF / 256, G, bx);
            pg8::EpiBf16<2> E{Rb, DFF, nullptr};
            pg8::gemm_phase<pg8::EpiBf16<2>, pg8::StaticOrder, true, true>(lds + RING_OFF, g, S, E, ptid);
        }
        SEAM(pb + 6);
        for (int rep_ = 0; rep_ < PHREP(8); ++rep_) if (PHEN(8) && IN(pb + 7)) {
            int ptid = threadIdx.x; asm volatile("" : "+v"(ptid)); const int lane = ptid & 63, wave = __builtin_amdgcn_readfirstlane(ptid >> 6), gw = vcu * NWAVES + wave; (void)lane; (void)gw;
            { SEpiF32Slab E{FSb}; for (int r3 = 0; r3 < PHREP(13); ++r3) mid_gemm(Rb + (size_t)MP * DFF, DFF, (const bf16*)(wl + WL_WDN), DFF, DFF / 4, DM / 64, 4, E, bx, G, (LAS char*)lds, ptid); }
            __syncthreads();
            pg8::Gemm g{Rb, (const bf16*)(wl + WL_WDN), DFF, DFF, DFF}; pg8::StaticOrder S; S.init(MP / 256, DM / 256, G, bx);
            pg8::EpiBf16<0> E{MIXb, DM, nullptr};
            pg8::gemm_phase<pg8::EpiBf16<0>, pg8::StaticOrder, true, true>(lds + RING_OFF, g, S, E, ptid);
        }
        SEAM(pb + 7);
        if (PHEN(9) && IN(pb + 8)) {
            int ptid = threadIdx.x; asm volatile("" : "+v"(ptid)); const int lane = ptid & 63, wave = __builtin_amdgcn_readfirstlane(ptid >> 6), gw = vcu * NWAVES + wave; (void)lane; (void)gw;
            for (int m0 = gw; m0 < M; m0 += 2 * NGW) { RowIO io[2]; bool valid[2];
#pragma unroll
                for (int r = 0; r < 2; ++r) { const int m = m0 + r * NGW; valid[r] = m < M; const int mm = valid[r] ? m : m0;
                    io[r].xold = nullptr; io[r].xbold = Hb + (size_t)mm * DM;
                    io[r].trow = mm < MP ? MIXb + (size_t)mm * DM : nullptr; io[r].slab = mm < MP ? nullptr : FSb + (size_t)(mm - MP) * DM;
                    io[r].xnew = (l + 1 < DEPTH) ? nullptr : P.out + (size_t)mm * DM; io[r].xb = (l + 1 < DEPTH) ? Hb + (size_t)mm * DM : nullptr; io[r].rs = RSb + mm; }
                resid_rows<2>(io, valid, P.nf_post + l * DM, lane); }
        }
        SEAM(pb + 8);
    }
#undef IN
#undef SEAM
}

extern "C" void kernel_launch(void* const* d_in, const int* in_sizes, int n_in, void* d_out, int out_size, void* d_ws, size_t ws_size, hipStream_t stream) {
    static int grid = 0;
    if (grid == 0) {
        if (n_in != 21 || (size_t)out_size != O_END || ws_size < WS_END) { fprintf(stderr, "kernel_launch: unexpected shapes: n_in %d out %d ws %zu (need %zu)\n", n_in, out_size, ws_size, (size_t)WS_END); grid = -1; return; }
        int dev = 0, cus = 0, per_cu = 0;
        if (hipGetDevice(&dev) != hipSuccess || hipDeviceGetAttribute(&cus, hipDeviceAttributeMultiprocessorCount, dev) != hipSuccess) { grid = -1; return; }
        if (hipFuncSetAttribute((const void*)fwd, hipFuncAttributeMaxDynamicSharedMemorySize, LDS_BYTES) != hipSuccess) { fprintf(stderr, "kernel_launch: hipFuncSetAttribute failed\n"); grid = -1; return; }
        if (hipOccupancyMaxActiveBlocksPerMultiprocessor(&per_cu, (const void*)fwd, NWAVES * 64, LDS_BYTES) != hipSuccess || per_cu < 1) fprintf(stderr, "kernel_launch: occupancy query reports %d\n", per_cu);
        (void)hipGetLastError();
        grid = cus;
    }
    if (grid < 0) return;
    if (hipMemsetAsync((char*)d_ws + WS_CTL, 0, CTL_ZERO_BYTES, stream) != hipSuccess) return;
    Args a{};
    Ptrs& p = a.p;
    p.x_p = (const float*)d_in[0]; p.x_s = (const float*)d_in[1]; p.cache_c = (const float*)d_in[2]; p.cache_r = (const float*)d_in[3]; p.ptab = (const int*)d_in[4];
    p.nm_pre = (const float*)d_in[5]; p.nm_post = (const float*)d_in[6]; p.w_in = (const float*)d_in[7]; p.q_norm = (const float*)d_in[8]; p.w_uq = (const float*)d_in[9];
    p.kv_norm = (const float*)d_in[10]; p.w_uk = (const float*)d_in[11]; p.w_uv = (const float*)d_in[12]; p.v_norm = (const float*)d_in[13]; p.w_sp = (const float*)d_in[14];
    p.b_sp = (const float*)d_in[15]; p.w_out = (const float*)d_in[16]; p.nf_pre = (const float*)d_in[17]; p.nf_post = (const float*)d_in[18]; p.w_up = (const float*)d_in[19]; p.w_dn = (const float*)d_in[20];
    p.out = (float*)d_out; p.ws = (unsigned char*)d_ws;
#if MK_ONE_LAUNCH
    a.ph_lo = 0; a.ph_hi = N_PHASES; a.one_launch = 1;
    hipLaunchKernelGGL(fwd, dim3(grid), dim3(NWAVES * 64), LDS_BYTES, stream, a);
#else
    for (int k = 0; k < N_PHASES; ++k) { a.ph_lo = k; a.ph_hi = k + 1; a.one_launch = 0;
        hipLaunchKernelGGL(fwd, dim3(grid), dim3(NWAVES * 64), LDS_BYTES, stream, a);
        if (hipPeekAtLastError() != hipSuccess) { fprintf(stderr, "kernel_launch: launch %d failed\n", k); break; } }
#endif
}
```

```cpp
#include <hip/hip_runtime.h>
#include <cstdio>
#include <cstdint>
#ifndef MK_ONE_LAUNCH
#define MK_ONE_LAUNCH 1
#endif
namespace pg8 {
#define PG8_LAS __attribute__((address_space(3)))
typedef unsigned short bf16_t;
typedef short bf16x8 __attribute__((ext_vector_type(8)));
typedef float f32x4 __attribute__((ext_vector_type(4)));
typedef unsigned u32x4 __attribute__((ext_vector_type(4)));
constexpr int BM = 256, BK = 64, HALF = 128, HTB = HALF * BK * 2  , STAGE_BYTES = 8 * HTB, NXCD = 8, WGM = 8;

__host__ __device__ __forceinline__ int lds_byte(int r, int c) { const int st = (r >> 4) * 2 + (c >> 5), rr = r & 15, cc = c & 31, ob = rr * 64 + cc * 2; return st * 1024 + (ob ^ (((ob >> 9) & 1) << 5)); }
__host__ __device__ __forceinline__ void stage_rc(int b, int& R, int& C) { const int st = b / 1024, sb = b % 1024, swz = sb ^ (((sb >> 9) & 1) << 5); R = (st >> 1) * 16 + swz / 64; C = (st & 1) * 32 + (swz % 64) / 2; }
__host__ __device__ __forceinline__ int perm32(int rho) { const int n = rho >> 4, i = rho & 15; return 8 * (i >> 2) + 4 * n + (i & 3); }

struct Unit { int pm, pn; };
struct Gemm { const bf16_t* A; const bf16_t* Bt; int lda, ldb, K; };

struct StaticOrder {
    int nM, nN, nwg, G, c;
    __host__ __device__ void init(int nM_, int nN_, int G_, int c_) { nM = nM_; nN = nN_; nwg = nM * nN; G = G_; c = c_; }
    __host__ __device__ bool next(int i, Unit& u) const {
        const long L = (long)i * G + c; if (L >= nwg) return false;
        int wgid = (int)L; { const int q = nwg / NXCD, r = nwg % NXCD, xcd = wgid % NXCD, off = wgid / NXCD; wgid = (xcd < r ? xcd * (q + 1) : r * (q + 1) + (xcd - r) * q) + off; }
        const int nig = WGM * nN, gid = wgid / nig, fm = gid * WGM, gsz = (nM - fm) < WGM ? (nM - fm) : WGM;
        u.pm = fm + ((wgid % nig) % gsz); u.pn = (wgid % nig) / gsz; return true;
    }
    __device__ __forceinline__ void a_ready(const Unit&) const {}
    __device__ __forceinline__ void done(const Unit&) const {}
};

__device__ __forceinline__ unsigned cvt_pk_bf16(float lo, float hi) { unsigned r; asm volatile("v_cvt_pk_bf16_f32 %0, %1, %2" : "=v"(r) : "v"(lo), "v"(hi)); return r; }

template <int ACT  > struct EpiBf16 {
    static constexpr bool PERM = true, AFTER_DRAIN = false;
    bf16_t* O; int ldc; const float* rs;
    __device__ __forceinline__ void operator()(const f32x4 (&acc)[2][2][4][2], const Unit& u, int wr, int wc, int fr, int fq) const {
        const int row0 = u.pm * BM + wr * 64 + fr; const int col0 = u.pn * BM + wc * 32 + 8 * fq;
#pragma unroll
        for (int ai = 0; ai < 2; ++ai)
#pragma unroll
            for (int m = 0; m < 4; ++m) { bf16_t* rowp = O + (size_t)(row0 + ai * HALF + m * 16) * ldc + col0; const float rsc = rs ? rs[row0 + ai * HALF + m * 16] : 1.0f;
#pragma unroll
                for (int bj = 0; bj < 2; ++bj) { f32x4 v0 = acc[ai][bj][m][0] * rsc, v1 = acc[ai][bj][m][1] * rsc;
                    if (ACT == 2) {
#pragma unroll
                        for (int e = 0; e < 4; ++e) { float a = v0[e] > 0.f ? v0[e] : 0.f; v0[e] = a * a; float b = v1[e] > 0.f ? v1[e] : 0.f; v1[e] = b * b; } }
                    u32x4 w; w.x = cvt_pk_bf16(v0[0], v0[1]); w.y = cvt_pk_bf16(v0[2], v0[3]); w.z = cvt_pk_bf16(v1[0], v1[1]); w.w = cvt_pk_bf16(v1[2], v1[3]);
                    *(u32x4*)(rowp + bj * HALF) = w; } }
    }
};

struct EpiZ {
    static constexpr bool PERM = true, AFTER_DRAIN = false;
    bf16_t* O; int ldc; float* ssq; float* ssv;
    __device__ __forceinline__ void operator()(const f32x4 (&acc)[2][2][4][2], const Unit& u, int wr, int wc, int fr, int fq) const {
        const int row0 = u.pm * BM + wr * 64 + fr; const int col0 = u.pn * BM + wc * 32 + 8 * fq;
        const bool doq = u.pn == 0, dov = u.pn >= 4;
#pragma unroll
        for (int ai = 0; ai < 2; ++ai)
#pragma unroll
            for (int m = 0; m < 4; ++m) { const int row = row0 + ai * HALF + m * 16; bf16_t* rowp = O + (size_t)row * ldc + col0; float s = 0.f;
#pragma unroll
                for (int bj = 0; bj < 2; ++bj) { const f32x4 v0 = acc[ai][bj][m][0], v1 = acc[ai][bj][m][1];
                    s += (v0[0] * v0[0] + v0[1] * v0[1]) + (v0[2] * v0[2] + v0[3] * v0[3]) + (v1[0] * v1[0] + v1[1] * v1[1]) + (v1[2] * v1[2] + v1[3] * v1[3]);
                    u32x4 w; w.x = cvt_pk_bf16(v0[0], v0[1]); w.y = cvt_pk_bf16(v0[2], v0[3]); w.z = cvt_pk_bf16(v1[0], v1[1]); w.w = cvt_pk_bf16(v1[2], v1[3]);
                    *(u32x4*)(rowp + bj * HALF) = w; }
                if (doq || dov) { s += __shfl_xor(s, 16); s += __shfl_xor(s, 32);
                    if (fq == 0) { float* d = doq ? ssq + (size_t)row * 4 + wc : ssv + (size_t)row * 8 + (u.pn - 4) * 4 + wc; *d = s; } } }
    }
};

struct EpiQ {
    static constexpr bool PERM = true, AFTER_DRAIN = false;
    bf16_t* Qn; bf16_t* Qr; const float* tab; float sc; int tmask; const float* ssq;
    __device__ __forceinline__ void operator()(const f32x4 (&acc)[2][2][4][2], const Unit& u, int wr, int wc, int fr, int fq) const {
        const int row0 = u.pm * BM + wr * 64 + fr;
        if (u.pn < 2) {
            const int col0 = u.pn * BM + wc * 32 + 8 * fq;
#pragma unroll
            for (int ai = 0; ai < 2; ++ai)
#pragma unroll
                for (int m = 0; m < 4; ++m) { const int row = row0 + ai * HALF + m * 16; bf16_t* rowp = Qn + (size_t)row * 512 + col0;
                    const f32x4 pq = *(const f32x4*)(ssq + (size_t)row * 4); const float scr = sc / sqrtf(((pq[0] + pq[1]) + (pq[2] + pq[3])) * (1.0f / 256.0f) + 1e-6f);
#pragma unroll
                    for (int bj = 0; bj < 2; ++bj) { const f32x4 v0 = acc[ai][bj][m][0] * scr, v1 = acc[ai][bj][m][1] * scr;
                        u32x4 w; w.x = cvt_pk_bf16(v0[0], v0[1]); w.y = cvt_pk_bf16(v0[2], v0[3]); w.z = cvt_pk_bf16(v1[0], v1[1]); w.w = cvt_pk_bf16(v1[2], v1[3]);
                        *(u32x4*)(rowp + bj * HALF) = w; } }
        } else {
            const int col0 = wc * 32 + 8 * fq;
#pragma unroll
            for (int ai = 0; ai < 2; ++ai)
#pragma unroll
                for (int m = 0; m < 4; ++m) { const int row = row0 + ai * HALF + m * 16; bf16_t* rowp = Qr + (size_t)row * 256 + col0;
                    const f32x4* tp = (const f32x4*)(tab + (size_t)(row & tmask) * 32 + 8 * fq);
                    const f32x4 t0 = tp[0], t1 = tp[1];
                    const f32x4 pq = *(const f32x4*)(ssq + (size_t)row * 4); const float sc = this->sc / sqrtf(((pq[0] + pq[1]) + (pq[2] + pq[3])) * (1.0f / 256.0f) + 1e-6f);
#pragma unroll
                    for (int bj = 0; bj < 2; ++bj) { const f32x4 v0 = acc[ai][bj][m][0], v1 = acc[ai][bj][m][1];
                        const float a0 = (v0[0] * t0[0] - v0[1] * t0[1]) * sc, a1 = (v0[1] * t0[0] + v0[0] * t0[1]) * sc;
                        const float a2 = (v0[2] * t0[2] - v0[3] * t0[3]) * sc, a3 = (v0[3] * t0[2] + v0[2] * t0[3]) * sc;
                        const float a4 = (v1[0] * t1[0] - v1[1] * t1[1]) * sc, a5 = (v1[1] * t1[0] + v1[0] * t1[1]) * sc;
                        const float a6 = (v1[2] * t1[2] - v1[3] * t1[3]) * sc, a7 = (v1[3] * t1[2] + v1[2] * t1[3]) * sc;
                        u32x4 w; w.x = cvt_pk_bf16(a0, a1); w.y = cvt_pk_bf16(a2, a3); w.z = cvt_pk_bf16(a4, a5); w.w = cvt_pk_bf16(a6, a7);
                        *(u32x4*)(rowp + bj * HALF) = w; }
                    asm volatile("" ::: "memory"); }
        }
    }
};

template <class Epi, class Sched, bool ALIGN_EPI = false, bool SP2 = false>
__device__ __forceinline__ void gemm_phase(PG8_LAS unsigned char* lds, const Gemm g, const Sched& S, const Epi& E, const int tid) {
    const int wid = __builtin_amdgcn_readfirstlane(tid >> 6), lane = tid & 63, wr = wid >> 2, wc = wid & 3, fr = lane & 15, fq = lane >> 4;
    int K_ = g.K; asm volatile("" : "+s"(K_));
    const int K = K_, nt = K / BK;
    unsigned voffA[2], voffB[2];
#pragma unroll
    for (int i = 0; i < 2; ++i) { int R, C; stage_rc(tid * 16 + i * 8192, R, C); const int Rb = Epi::PERM ? ((R & ~31) + perm32(R & 31)) : R;
        voffA[i] = (unsigned)(R * g.lda + C) * 2u; voffB[i] = (unsigned)(Rb * g.ldb + C) * 2u; }
    const size_t kstep = (size_t)(BK * 2);
    const size_t hstepA = (size_t)HALF * g.lda * 2, hstepB = (size_t)HALF * g.ldb * 2;
    const size_t tstepA = 2 * hstepA, tstepB = 2 * hstepB;
    const unsigned ldsw = (unsigned)wid * 1024u;
    const int aoff = lds_byte(wr * 64 + fr, fq * 8), boff = lds_byte(wc * 32 + fr, fq * 8);
#define PG8_SA(b, h) (((b) * 2 + (h)) * HTB)
#define PG8_SB(b, h) ((4 + (b) * 2 + (h)) * HTB)
#define PG8_STAGE(bufoff, gbase, voff) do { _Pragma("unroll") for (int _i = 0; _i < 2; ++_i) \
        __builtin_amdgcn_global_load_lds((const unsigned*)((const char*)(gbase) + (voff)[_i]), (PG8_LAS unsigned*)(lds + (bufoff) + ldsw + _i * 8192), 16, 0, 0); } while (0)
#define PG8_LDA(dst, b, h) do { _Pragma("unroll") for (int m = 0; m < 4; ++m) _Pragma("unroll") for (int k = 0; k < 2; ++k) dst[m][k] = *(const PG8_LAS bf16x8*)(lds + PG8_SA(b, h) + aoff + m * 2048 + k * 1024); } while (0)
#define PG8_LDB(dst, b, h) do { _Pragma("unroll") for (int n = 0; n < 2; ++n) _Pragma("unroll") for (int k = 0; k < 2; ++k) dst[n][k] = *(const PG8_LAS bf16x8*)(lds + PG8_SB(b, h) + boff + n * 2048 + k * 1024); } while (0)
#define PG8_MMA(ai, bj, At, Bt) do { __builtin_amdgcn_s_setprio(1); _Pragma("unroll") for (int m = 0; m < 4; ++m) _Pragma("unroll") for (int n = 0; n < 2; ++n) _Pragma("unroll") for (int k = 0; k < 2; ++k) \
        acc[ai][bj][m][n] = __builtin_amdgcn_mfma_f32_16x16x32_bf16(Bt[n][k], At[m][k], acc[ai][bj][m][n], 0, 0, 0); __builtin_amdgcn_s_setprio(0); } while (0)
#define PG8_WAIT_V(n) asm volatile("s_waitcnt vmcnt(" #n ")" ::: "memory")
#define PG8_WAIT_L(n) asm volatile("s_waitcnt lgkmcnt(" #n ")" ::: "memory")
#define PG8_BAR __builtin_amdgcn_s_barrier()
#define PG8_SCHED __builtin_amdgcn_sched_barrier(0)
    Unit cur, nxt; int ui = 0;
    if (!S.next(0, cur)) return;
    f32x4 acc[2][2][4][2];
#pragma unroll
    for (int a = 0; a < 2; ++a)
#pragma unroll
        for (int b = 0; b < 2; ++b)
#pragma unroll
            for (int m = 0; m < 4; ++m)
#pragma unroll
                for (int n = 0; n < 2; ++n) acc[a][b][m][n] = (f32x4){0.f, 0.f, 0.f, 0.f};
    bf16x8 At[4][2], B0[2][2], B1[2][2];
    const char* cA = (const char*)g.A + (size_t)cur.pm * tstepA; const char* cB = (const char*)g.Bt + (size_t)cur.pn * tstepB;
    S.a_ready(cur);
    if constexpr (SP2) {
        PG8_STAGE(PG8_SB(0, 0), cB, voffB); PG8_STAGE(PG8_SB(0, 1), cB + hstepB, voffB); PG8_STAGE(PG8_SA(0, 0), cA, voffA); PG8_STAGE(PG8_SA(0, 1), cA + hstepA, voffA);
        if (wr == 1) PG8_BAR;
        PG8_WAIT_V(2); PG8_BAR;
        PG8_STAGE(PG8_SB(1, 0), cB + kstep, voffB); PG8_STAGE(PG8_SA(1, 0), cA + kstep, voffA); PG8_STAGE(PG8_SB(1, 1), cB + hstepB + kstep, voffB);
        PG8_WAIT_V(6); PG8_BAR;
    } else {
        PG8_STAGE(PG8_SB(0, 0), cB, voffB); PG8_STAGE(PG8_SA(0, 0), cA, voffA); PG8_STAGE(PG8_SB(0, 1), cB + hstepB, voffB); PG8_STAGE(PG8_SA(0, 1), cA + hstepA, voffA);
        if (wr == 1) PG8_BAR;
        PG8_WAIT_V(4); PG8_BAR;
        PG8_STAGE(PG8_SB(1, 0), cB + kstep, voffB); PG8_STAGE(PG8_SA(1, 0), cA + kstep, voffA); PG8_STAGE(PG8_SB(1, 1), cB + hstepB + kstep, voffB);
        PG8_WAIT_V(6); PG8_BAR;
    }
    for (;;) {
        const bool has_next = S.next(ui + 1, nxt);
        const char* nA = has_next ? (const char*)g.A + (size_t)nxt.pm * tstepA : cA; const char* nB = has_next ? (const char*)g.Bt + (size_t)nxt.pn * tstepB : cB;
#pragma unroll 1
        for (int t = 0; t < nt; t += 2) {
            const bool last = (t == nt - 2);
            const char* a1 = cA + (size_t)(t + 1) * kstep;
            const char* a2 = last ? nA : cA + (size_t)(t + 2) * kstep; const char* b2 = last ? nB : cB + (size_t)(t + 2) * kstep;
            const char* a3 = a2 + kstep; const char* b3 = b2 + kstep;
            if (last && has_next) S.a_ready(nxt);
            if constexpr (SP2) {
            PG8_LDB(B0, 0, 0); PG8_LDB(B1, 0, 1); PG8_SCHED; PG8_LDA(At, 0, 0); PG8_STAGE(PG8_SA(1, 1), a1 + hstepA, voffA);
            PG8_WAIT_V(8); PG8_WAIT_L(0); PG8_BAR; PG8_MMA(0, 0, At, B0); PG8_MMA(0, 1, At, B1); PG8_BAR; PG8_SCHED;
            PG8_LDA(At, 0, 1); PG8_STAGE(PG8_SB(0, 0), b2, voffB); PG8_STAGE(PG8_SB(0, 1), b2 + hstepB, voffB); PG8_STAGE(PG8_SA(0, 0), a2, voffA);
            PG8_WAIT_V(8); PG8_WAIT_L(0); PG8_BAR; PG8_MMA(1, 0, At, B0); PG8_MMA(1, 1, At, B1); PG8_BAR; PG8_SCHED;
            PG8_LDB(B0, 1, 0); PG8_LDB(B1, 1, 1); PG8_SCHED; PG8_LDA(At, 1, 0); PG8_STAGE(PG8_SA(0, 1), a2 + hstepA, voffA);
            PG8_WAIT_V(8); PG8_WAIT_L(0); PG8_BAR; PG8_MMA(0, 0, At, B0); PG8_MMA(0, 1, At, B1); PG8_BAR; PG8_SCHED;
            PG8_LDA(At, 1, 1); PG8_STAGE(PG8_SB(1, 0), b3, voffB); PG8_STAGE(PG8_SB(1, 1), b3 + hstepB, voffB); PG8_STAGE(PG8_SA(1, 0), a3, voffA);
            PG8_WAIT_V(8); PG8_WAIT_L(0); PG8_BAR; PG8_MMA(1, 0, At, B0); PG8_MMA(1, 1, At, B1); PG8_BAR; PG8_SCHED;
            } else {
            PG8_LDB(B0, 0, 0); PG8_SCHED; PG8_LDA(At, 0, 0); PG8_STAGE(PG8_SA(1, 1), a1 + hstepA, voffA);
            PG8_WAIT_L(8); PG8_BAR; PG8_WAIT_L(0); PG8_MMA(0, 0, At, B0); PG8_BAR; PG8_SCHED;
            PG8_LDB(B1, 0, 1); PG8_STAGE(PG8_SB(0, 0), b2, voffB);
            PG8_BAR; PG8_WAIT_L(0); PG8_MMA(0, 1, At, B1); PG8_BAR;
            PG8_LDA(At, 0, 1); PG8_STAGE(PG8_SA(0, 0), a2, voffA);
            PG8_BAR; PG8_WAIT_L(0); PG8_MMA(1, 0, At, B0); PG8_BAR; PG8_SCHED;
            PG8_STAGE(PG8_SB(0, 1), b2 + hstepB, voffB);
            PG8_WAIT_V(6); PG8_BAR; PG8_MMA(1, 1, At, B1); PG8_BAR;
            PG8_LDB(B0, 1, 0); PG8_SCHED; PG8_LDA(At, 1, 0); PG8_STAGE(PG8_SA(0, 1), a2 + hstepA, voffA);
            PG8_WAIT_L(8); PG8_BAR; PG8_WAIT_L(0); PG8_MMA(0, 0, At, B0); PG8_BAR; PG8_SCHED;
            PG8_LDB(B1, 1, 1); PG8_STAGE(PG8_SB(1, 0), b3, voffB);
            PG8_BAR; PG8_WAIT_L(0); PG8_MMA(0, 1, At, B1); PG8_BAR;
            PG8_LDA(At, 1, 1); PG8_STAGE(PG8_SA(1, 0), a3, voffA);
            PG8_BAR; PG8_WAIT_L(0); PG8_MMA(1, 0, At, B0); PG8_BAR; PG8_SCHED;
            PG8_STAGE(PG8_SB(1, 1), b3 + hstepB, voffB);
            PG8_WAIT_V(6); PG8_BAR; PG8_MMA(1, 1, At, B1); PG8_BAR;
            }
        }
        if constexpr (ALIGN_EPI) { if (wr == 0) PG8_BAR; }
        if constexpr (!Epi::AFTER_DRAIN) { E(acc, cur, wr, wc, fr, fq); S.done(cur); }
        if (!has_next) break;
#pragma unroll
        for (int a = 0; a < 2; ++a)
#pragma unroll
            for (int b = 0; b < 2; ++b)
#pragma unroll
                for (int m = 0; m < 4; ++m)
#pragma unroll
                    for (int n = 0; n < 2; ++n) acc[a][b][m][n] = (f32x4){0.f, 0.f, 0.f, 0.f};
        cur = nxt; cA = nA; cB = nB; ++ui;
        if constexpr (ALIGN_EPI) { if (wr == 1) PG8_BAR; }
    }
    PG8_WAIT_V(0);
    if constexpr (!ALIGN_EPI) { if (wr == 0) PG8_BAR; }
    PG8_BAR;
#undef PG8_SA
#undef PG8_SB
#undef PG8_STAGE
#undef PG8_LDA
#undef PG8_LDB
#undef PG8_MMA
#undef PG8_WAIT_V
#undef PG8_WAIT_L
#undef PG8_BAR
#undef PG8_SCHED
}
}
constexpr int DM = 1024, NB = 16, SEQ = 2048, DEPTH = 2, DB = 128, DT = 4, PAST = 8192, PAGE = 128;
constexpr int NH = 8, NOPE = 64, ROPE = 32, VD = 64, QL = 256, KVL = 128, GMW = 512, CHUNK = 128;
constexpr int INW = 1440, ZW = 1536, DFF = 4096;
constexpr int MP = NB * SEQ, MS = DB * DT, M = MP + MS;
constexpr int NPAGES = PAST / PAGE, NPHYS = (DB * NPAGES * 5) / 4;
constexpr float EPS = 1e-6f;
constexpr float C2 = 0.10206207261596575f * 1.4426950408889634f;
constexpr int NPOS = SEQ + DT;

constexpr size_t O_Y = 0;
constexpr size_t O_CKV_P = (size_t)M * DM;
constexpr size_t O_KR_P = O_CKV_P + (size_t)DEPTH * MP * KVL;
constexpr size_t O_CKV_S = O_KR_P + (size_t)DEPTH * MP * ROPE;
constexpr size_t O_KR_S = O_CKV_S + (size_t)DEPTH * MS * KVL;
constexpr size_t O_V_S = O_KR_S + (size_t)DEPTH * MS * ROPE;
constexpr size_t O_END = O_V_S + (size_t)DEPTH * MS * GMW;

constexpr size_t MiB = 1u << 20;
constexpr size_t WS_CTL = 0, CTL_ZERO_BYTES = 1 * MiB;
constexpr size_t WS_WL = 2 * MiB, WL_STRIDE = 24 * MiB;
constexpr size_t WL_WIN = 0, WL_WUQ = 3 * MiB, WL_WQS = 3 * MiB + 512 * 1024, WL_WKV = 4 * MiB + 256 * 1024, WL_WSP = 4 * MiB + 512 * 1024,
                 WL_WOUT = 5 * MiB, WL_WUP = 7 * MiB, WL_WDN = 15 * MiB;
constexpr size_t WS_ROPE = 50 * MiB;
constexpr size_t WS_SSQ = 60 * MiB, WS_SSV = 61 * MiB;
constexpr size_t WS_RS = 62 * MiB;
constexpr size_t WS_H = 64 * MiB;
constexpr size_t WS_Z = 130 * MiB;
constexpr size_t WS_QN = 228 * MiB, WS_QR = 260 * MiB;
constexpr size_t WS_KV = 276 * MiB;
constexpr size_t WS_QS = 340 * MiB;
constexpr size_t WS_AG = 342 * MiB;
constexpr size_t WS_MIX = 408 * MiB;
constexpr size_t WS_FS = 474 * MiB;
constexpr size_t WS_R = 484 * MiB;
constexpr size_t WS_END = 746 * MiB;

constexpr int CW_TMO = 0, CW_CODE = 1;
constexpr int CW_BAR = 4096;
constexpr int CW_Q = 8192;

constexpr int RING_OFF = 0, RING_BYTES = 131072;
constexpr int LDSCTL_OFF = RING_BYTES, MISC_OFF = LDSCTL_OFF + 320;
constexpr int LDS_BYTES = 147456;

#define GAS __attribute__((address_space(1)))
#define LAS __attribute__((address_space(3)))
typedef unsigned short bf16;
typedef unsigned v4u __attribute__((ext_vector_type(4)));
typedef unsigned v2u __attribute__((ext_vector_type(2)));
typedef float f32x4 __attribute__((ext_vector_type(4)));
typedef float f32x2 __attribute__((ext_vector_type(2)));
typedef float f32x16 __attribute__((ext_vector_type(16)));
typedef short bf16x8 __attribute__((ext_vector_type(8)));
typedef short s16x4 __attribute__((ext_vector_type(4)));
typedef GAS unsigned gu32;
#define RLX_AGENT __ATOMIC_RELAXED, __HIP_MEMORY_SCOPE_AGENT
#define LDS_WAIT() asm volatile("s_waitcnt lgkmcnt(0)" ::: "memory")
#define VM_WAIT() asm volatile("s_waitcnt vmcnt(0)" ::: "memory")
__device__ __forceinline__ unsigned f2bf(float f) { unsigned u = __builtin_bit_cast(unsigned, f); return (u + 0x7fffu + ((u >> 16) & 1u)) >> 16; }
__device__ __forceinline__ unsigned pk2(float lo, float hi) { return f2bf(lo) | (f2bf(hi) << 16); }
__device__ __forceinline__ float bflo(unsigned w) { return __builtin_bit_cast(float, w << 16); }
__device__ __forceinline__ float bfhi(unsigned w) { return __builtin_bit_cast(float, w & 0xffff0000u); }
__device__ __forceinline__ float bf2f(bf16 h) { return __builtin_bit_cast(float, (unsigned)h << 16); }
__device__ __forceinline__ int crow(int r, int hi) { return (r & 3) + 8 * (r >> 2) + 4 * hi; }
__device__ __forceinline__ float wave_sum(float v) {
#pragma unroll
    for (int o = 1; o < 64; o <<= 1) v += __shfl_xor(v, o);
    return v;
}
__device__ __forceinline__ s16x4 vtr(const LAS char* p) { return __builtin_bit_cast(s16x4, __builtin_amdgcn_ds_read_tr16_b64_v4i16((LAS s16x4*)p)); }
__device__ __forceinline__ bf16x8 cat8(s16x4 a, s16x4 b) { return (bf16x8){a[0], a[1], a[2], a[3], b[0], b[1], b[2], b[3]}; }
__device__ __forceinline__ bf16x8 pack8(float a0, float a1, float a2, float a3, float a4, float a5, float a6, float a7) {
    v4u w; w.x = pg8::cvt_pk_bf16(a0, a1); w.y = pg8::cvt_pk_bf16(a2, a3); w.z = pg8::cvt_pk_bf16(a4, a5); w.w = pg8::cvt_pk_bf16(a6, a7); return __builtin_bit_cast(bf16x8, w); }

struct Ptrs {
    const float *x_p, *x_s, *cache_c, *cache_r; const int* ptab;
    const float *nm_pre, *nm_post, *w_in, *q_norm, *w_uq, *kv_norm, *w_uk, *w_uv, *v_norm, *w_sp, *b_sp, *w_out, *nf_pre, *nf_post, *w_up, *w_dn;
    float* out; unsigned char* ws;
};

template <int MODE>
__device__ __forceinline__ int dest_row(int n, int row_off) {
    if (MODE == 0) return row_off + n;
    if (MODE == 1) return n < 416 ? n : n + 96;
    const int h = n / 96, e = n - h * 96;
    if (MODE == 2) return e < 64 ? h * 64 + e : 512 + h * 32 + 2 * ((e - 64) & 15) + ((e - 64) >> 4);
    return e >= 64 ? 1024 + h * 32 + (e - 64) : -1;
}
template <int MODE>
__device__ __forceinline__ void p0_transpose_item(const float* W, int K, int N, bf16* WT, int row_off, LAS float* scr, int item, int lane, const float* gk = nullptr) {
    const int nblk = N / 32, ngrp = (nblk + 3) >> 2, kb = item / ngrp, g = item - kb * ngrp, k0 = 64 * kb;
    f32x4 w[4][8];
#pragma unroll
    for (int sb = 0; sb < 4; ++sb) { const int nb = 4 * g + sb; if (nb < nblk) {
#pragma unroll
        for (int i = 0; i < 8; ++i) { const int kk = 8 * i + (lane >> 3); w[sb][i] = *(const GAS f32x4*)(W + (size_t)(k0 + kk) * N + 32 * nb + 4 * (lane & 7)); } } }
    const int c = lane & 7;
    float gv[8];
#pragma unroll
    for (int e = 0; e < 8; ++e) gv[e] = gk ? gk[k0 + 8 * c + e] : 1.0f;
#pragma unroll
    for (int sb = 0; sb < 4; ++sb) { const int nb = 4 * g + sb; if (nb < nblk) { const int n0 = 32 * nb;
#pragma unroll
        for (int i = 0; i < 8; ++i) { const int kk = 8 * i + (lane >> 3); LAS float* d = scr + kk * 33 + 4 * (lane & 7); d[0] = w[sb][i].x; d[1] = w[sb][i].y; d[2] = w[sb][i].z; d[3] = w[sb][i].w; }
        LDS_WAIT(); asm volatile("" ::: "memory");
#pragma unroll
        for (int j = 0; j < 4; ++j) { const int n = (lane >> 3) + 8 * j; const LAS float* s = scr + (8 * c) * 33 + n;
            const float v0 = s[0 * 33], v1 = s[1 * 33], v2 = s[2 * 33], v3 = s[3 * 33], v4 = s[4 * 33], v5 = s[5 * 33], v6 = s[6 * 33], v7 = s[7 * 33];
            v4u o; o.x = pk2(v0 * gv[0], v1 * gv[1]); o.y = pk2(v2 * gv[2], v3 * gv[3]); o.z = pk2(v4 * gv[4], v5 * gv[5]); o.w = pk2(v6 * gv[6], v7 * gv[7]);
            const int dr = dest_row<MODE>(n0 + n, row_off);
            if (dr >= 0) *(GAS v4u*)(WT + (size_t)dr * K + k0 + 8 * c) = o;
            if (MODE == 2) { const int dr2 = dest_row<3>(n0 + n, 0);
                if (dr2 >= 0) { v4u o2; o2.x = pk2(v0, v1); o2.y = pk2(v2, v3); o2.z = pk2(v4, v5); o2.w = pk2(v6, v7); *(GAS v4u*)(WT + (size_t)(WL_WQS - WL_WUQ) / 2 + (size_t)dr2 * K + k0 + 8 * c) = o2; } } }
        LDS_WAIT(); asm volatile("" ::: "memory"); } }
}

__device__ __forceinline__ void rope_entry(int pos, int i, float& c, float& s) {
    const double f = exp2(-(double)i * (13.287712379549449 / 16.0));
    const double f2 = f * f; double cs = 1.0, sn = f, tc = 1.0, ts = f;
#pragma unroll 1
    for (int k = 1; k <= 12; ++k) { tc *= -f2 / (double)((2 * k - 1) * (2 * k)); ts *= -f2 / (double)((2 * k) * (2 * k + 1)); cs += tc; sn += ts; }
    double rc = 1.0, rs = 0.0, bc = cs, bs = sn; int p = pos;
#pragma unroll 1
    for (int b = 0; b < 14; ++b) { if (p & 1) { const double nc = rc * bc - rs * bs, ns = rc * bs + rs * bc; rc = nc; rs = ns; }
        const double nbc = bc * bc - bs * bs, nbs = 2.0 * bc * bs; bc = nbc; bs = nbs; p >>= 1; }
    c = (float)rc; s = (float)rs;
}

template <int NR>
__device__ __forceinline__ void rows_to_bf16_rs(const float* const (&xrow)[NR], bf16* const (&orow)[NR], float* const (&rs)[NR], const bool (&valid)[NR], int lane) {
    f32x4 v[NR][4];
#pragma unroll
    for (int r = 0; r < NR; ++r) if (valid[r]) {
#pragma unroll
        for (int jj = 0; jj < 2; ++jj) { const GAS f32x4* xr = (const GAS f32x4*)(xrow[r] + jj * 512 + 8 * lane); v[r][2 * jj] = xr[0]; v[r][2 * jj + 1] = xr[1]; } }
#pragma unroll
    for (int r = 0; r < NR; ++r) if (valid[r]) {
        float s = 0.f;
#pragma unroll
        for (int j = 0; j < 4; ++j) s += (v[r][j].x * v[r][j].x + v[r][j].y * v[r][j].y) + (v[r][j].z * v[r][j].z + v[r][j].w * v[r][j].w);
        const float rstd = 1.0f / sqrtf(wave_sum(s) * (1.f / DM) + EPS);
        if (lane == 0) *rs[r] = rstd;
#pragma unroll
        for (int jj = 0; jj < 2; ++jj) { const f32x4 a = v[r][2 * jj] * rstd, b2 = v[r][2 * jj + 1] * rstd;
            v4u o; o.x = pk2(a.x, a.y); o.y = pk2(a.z, a.w); o.z = pk2(b2.x, b2.y); o.w = pk2(b2.z, b2.w);
            *(GAS v4u*)(orow[r] + jj * 512 + 8 * lane) = o; } }
}

template <class Epi>
__device__ __forceinline__ void small_gemm(const bf16* A, int lda, const bf16* Bt, int ldb, int Kper, int ntn, int KS, const Epi& E, int gw, int ngw, int lane) {
    const int r32 = lane & 31, hi = lane >> 5;
    const int nitem = 16 * ntn * KS;
    for (int item = gw; item < nitem; item += ngw) {
        const int tm = item & 15, rest = item >> 4, tn = rest % ntn, ks = rest / ntn;
        const bf16* ap = A + (size_t)(tm * 32 + r32) * lda + ks * Kper + hi * 8;
        const bf16* bp = Bt + (size_t)(tn * 32 + r32) * ldb + ks * Kper + hi * 8;
        f32x16 acc = {};
#pragma unroll 1
        for (int k = 0; k < Kper; k += 128) {
            bf16x8 a[8], b[8];
#pragma unroll
            for (int j = 0; j < 8; ++j) { a[j] = *(const GAS bf16x8*)(ap + k + j * 16); b[j] = *(const GAS bf16x8*)(bp + k + j * 16); }
#pragma unroll
            for (int j = 0; j < 8; ++j) acc = __builtin_amdgcn_mfma_f32_32x32x16_bf16(b[j], a[j], acc, 0, 0, 0);
        }
        E(acc, tm * 32 + r32, tn * 32, ks, hi);
    }
}
template <int ACT> struct SEpiBf16 {
    bf16* O; int ldc; const float* rs;
    __device__ __forceinline__ void operator()(const f32x16& acc, int row, int col0, int ks, int hi) const {
        bf16* rp = O + (size_t)row * ldc + col0 + 4 * hi; const float rsc = rs ? rs[row] : 1.0f;
#pragma unroll
        for (int q = 0; q < 4; ++q) { float v[4];
#pragma unroll
            for (int e = 0; e < 4; ++e) { float x = acc[4 * q + e] * rsc; if (ACT == 2) { x = x > 0.f ? x : 0.f; x = x * x; } v[e] = x; }
            v2u w; w.x = pk2(v[0], v[1]); w.y = pk2(v[2], v[3]); *(GAS v2u*)(rp + 8 * q) = w; }
    }
};
struct SEpiF32Slab {
    float* O;
    __device__ __forceinline__ void operator()(const f32x16& acc, int row, int col0, int ks, int hi) const {
        float* rp = O + ((size_t)ks * MS + row) * DM + col0 + 4 * hi;
#pragma unroll
        for (int q = 0; q < 4; ++q) *(GAS f32x4*)(rp + 8 * q) = (f32x4){acc[4 * q], acc[4 * q + 1], acc[4 * q + 2], acc[4 * q + 3]};
    }
};
struct SEpiQs {
    bf16* O; const float* tab; float sc;
    __device__ __forceinline__ void operator()(const f32x16& acc, int row, int col0, int ks, int hi) const {
        bf16* rp = O + (size_t)row * 1280 + col0 + 4 * hi;
        float v[16];
        if (col0 < 1024) {
#pragma unroll
            for (int r = 0; r < 16; ++r) v[r] = acc[r] * sc;
        } else {
            const float* tp = tab + (size_t)(SEQ + (row & 3)) * 32;
#pragma unroll
            for (int r = 0; r < 8; ++r) { const int i = crow(r, hi); const float c = tp[2 * i], s = tp[2 * i + 1]; const float x1 = acc[r], x2 = acc[r + 8];
                v[r] = (x1 * c - x2 * s) * sc; v[r + 8] = (x2 * c + x1 * s) * sc; }
        }
#pragma unroll
        for (int q = 0; q < 4; ++q) { v2u w; w.x = pk2(v[4 * q], v[4 * q + 1]); w.y = pk2(v[4 * q + 2], v[4 * q + 3]); *(GAS v2u*)(rp + 8 * q) = w; }
    }
};
#define XB_TMO      128
#define XB_XCNT(j)  (256  + 64 * (j))
#define XB_XSUB(j)  (1280 + 64 * (j))
#define XB_XGEN(j)  (2304 + 64 * (j))
#define XB_TOP      3328
#define XB_TOPGEN   3392
#define XCD_BAR_WORDS 3456
#define XB_SPIN_CAP (1u << 18)

__device__ __forceinline__ unsigned xb_ld(unsigned* p)              { return __hip_atomic_load(p, __ATOMIC_RELAXED, __HIP_MEMORY_SCOPE_AGENT); }
__device__ __forceinline__ unsigned xb_add(unsigned* p, unsigned v) { return __hip_atomic_fetch_add(p, v, __ATOMIC_RELAXED, __HIP_MEMORY_SCOPE_AGENT); }
__device__ __forceinline__ unsigned xb_xcc_id() { return (unsigned)__builtin_amdgcn_s_getreg((3 << 11) | 20) & 0xFu; }
#define XB_SPIN(cond, bar) do { unsigned _sp = 0; while (cond) { __builtin_amdgcn_s_sleep(1); \
    if ((++_sp & 255u) == 0u) { if (xb_ld(&(bar)[XB_TMO])) break; if (_sp > XB_SPIN_CAP) { atomicAdd(&(bar)[XB_TMO], 1u); break; } } } } while (0)

struct XcdBarrier {
    unsigned* bar; unsigned x;
    volatile LAS unsigned* st;
};

__device__ __forceinline__ XcdBarrier xcd_barrier_post(unsigned* bar, volatile LAS unsigned* st) {
    XcdBarrier b; b.bar = bar; b.x = xb_xcc_id(); b.st = st;
    if (threadIdx.x == 0) (void)xb_add(&bar[XB_XCNT(b.x)], 1u);
    return b;
}
__device__ __forceinline__ void xcd_barrier_complete(unsigned* bar, unsigned x, unsigned& nloc, unsigned& nx) {
    const unsigned G = gridDim.x * gridDim.y * gridDim.z;
    unsigned sum, cnt, mine, sp = 0u;
    for (;;) {
        sum = 0u; cnt = 0u; mine = 0u;
#pragma unroll
        for (unsigned j = 0; j < 16; ++j) { const unsigned c = xb_ld(&bar[XB_XCNT(j)]); sum += c; cnt += (c > 0u) ? 1u : 0u; mine = (j == x) ? c : mine; }
        if (sum == G) break;
        __builtin_amdgcn_s_sleep(1);
        if ((++sp & 255u) == 0u) { if (xb_ld(&bar[XB_TMO])) break; if (sp > XB_SPIN_CAP) { atomicAdd(&bar[XB_TMO], 1u); break; } }
    }
    nloc = mine > 0u ? mine : 1u; nx = cnt > 0u ? cnt : 1u;
}

__device__ __forceinline__ void xcd_barrier(const XcdBarrier& b) {
    asm volatile("s_waitcnt vmcnt(0)" ::: "memory");
    __syncthreads();
    if (threadIdx.x == 0) {
        unsigned* bar = b.bar;
        __builtin_amdgcn_s_waitcnt(0);
        unsigned nloc = b.st[0], nx = b.st[1];
        if (nloc == 0u) { xcd_barrier_complete(bar, b.x, nloc, nx); b.st[0] = nloc; b.st[1] = nx; }
        const unsigned old = xb_add(&bar[XB_XSUB(b.x)], 1u);
        const unsigned gen = old / nloc;
        if (old + 1u == (gen + 1u) * nloc) {
            __builtin_amdgcn_fence(__ATOMIC_RELEASE, "agent");
            asm volatile("s_waitcnt vmcnt(0)" ::: "memory");
            const unsigned og = xb_add(&bar[XB_TOP], 1u);
            const unsigned tg = og / nx;
            if (og + 1u == (tg + 1u) * nx) xb_add(&bar[XB_TOPGEN], 1u);
            else XB_SPIN(xb_ld(&bar[XB_TOPGEN]) == tg, bar);
            __builtin_amdgcn_fence(__ATOMIC_ACQUIRE, "agent");
            xb_add(&bar[XB_XGEN(b.x)], 1u);
            asm volatile("s_waitcnt vmcnt(0)" ::: "memory");
        } else {
            XB_SPIN(xb_ld(&bar[XB_XGEN(b.x)]) == gen, bar);
            __builtin_amdgcn_fence(__ATOMIC_ACQUIRE, "agent");
            asm volatile("s_waitcnt vmcnt(0)" ::: "memory");
        }
    }
    __syncthreads();
}
__device__ __forceinline__ void postproj_row(const Ptrs& P, int l, int row, int lane) {
    bf16* zr = (bf16*)(P.ws + WS_Z) + (size_t)row * ZW;
    const v2u qw = *(const GAS v2u*)(zr + 4 * lane);
    const unsigned cw = *(const GAS unsigned*)(zr + 256 + 2 * lane);
    const v4u vw = *(const GAS v4u*)(zr + 1024 + 8 * lane);
    float kx1 = 0.f, kx2 = 0.f;
    if (lane < 16) { kx1 = bf2f(zr[384 + lane]); kx2 = bf2f(zr[400 + lane]); }
    const float q0 = bflo(qw.x), q1 = bfhi(qw.x), q2 = bflo(qw.y), q3 = bfhi(qw.y);
    const float c0 = bflo(cw), c1 = bfhi(cw);
    float vv[8] = {bflo(vw.x), bfhi(vw.x), bflo(vw.y), bfhi(vw.y), bflo(vw.z), bfhi(vw.z), bflo(vw.w), bfhi(vw.w)};
    float sq = (q0 * q0 + q1 * q1) + (q2 * q2 + q3 * q3), sc = c0 * c0 + c1 * c1, sv = 0.f;
#pragma unroll
    for (int e = 0; e < 8; ++e) sv += vv[e] * vv[e];
    sq = wave_sum(sq); sc = wave_sum(sc); sv = wave_sum(sv);
    const float rq = 1.0f / sqrtf(sq * (1.f / QL) + EPS), rc = 1.0f / sqrtf(sc * (1.f / KVL) + EPS), rv = 1.0f / sqrtf(sv * (1.f / GMW) + EPS);
    const bool samp = row >= MP; const int rs = row - MP;
    const int pos_idx = samp ? SEQ + (rs & 3) : (row & (SEQ - 1));
    { const f32x4 g = *(const f32x4*)(P.q_norm + l * QL + 4 * lane);
      v2u o; o.x = pk2(q0 * rq * g.x, q1 * rq * g.y); o.y = pk2(q2 * rq * g.z, q3 * rq * g.w); *(GAS v2u*)(zr + 4 * lane) = o; }
    { const f32x2 g = *(const f32x2*)(P.kv_norm + l * KVL + 2 * lane); const float a = c0 * rc * g.x, b = c1 * rc * g.y;
      *(GAS unsigned*)(zr + 256 + 2 * lane) = pk2(a, b);
      float* op = samp ? P.out + O_CKV_S + ((size_t)l * MS + rs) * KVL : P.out + O_CKV_P + ((size_t)l * MP + row) * KVL;
      *(GAS f32x2*)(op + 2 * lane) = (f32x2){a, b}; }
    if (lane < 16) { const f32x2 cs = *(const f32x2*)((const float*)(P.ws + WS_ROPE) + (size_t)pos_idx * 32 + 2 * lane);
      const float y1 = kx1 * cs.x - kx2 * cs.y, y2 = kx2 * cs.x + kx1 * cs.y;
      *(GAS unsigned*)(zr + 384 + 2 * lane) = pk2(y1, y2);
      float* op = samp ? P.out + O_KR_S + ((size_t)l * MS + rs) * ROPE : P.out + O_KR_P + ((size_t)l * MP + row) * ROPE;
      op[lane] = y1; op[16 + lane] = y2; }
    { const f32x4 g0 = *(const f32x4*)(P.v_norm + l * GMW + 8 * lane), g1 = *(const f32x4*)(P.v_norm + l * GMW + 8 * lane + 4);
      const float gg[8] = {g0.x, g0.y, g0.z, g0.w, g1.x, g1.y, g1.z, g1.w};
#pragma unroll
      for (int e = 0; e < 8; ++e) vv[e] = vv[e] * rv * gg[e];
      v4u o; o.x = pk2(vv[0], vv[1]); o.y = pk2(vv[2], vv[3]); o.z = pk2(vv[4], vv[5]); o.w = pk2(vv[6], vv[7]);
      *(GAS v4u*)(zr + 1024 + 8 * lane) = o;
      if (samp) { float* op = P.out + O_V_S + ((size_t)l * MS + rs) * GMW + 8 * lane;
        *(GAS f32x4*)op = (f32x4){vv[0], vv[1], vv[2], vv[3]}; *(GAS f32x4*)(op + 4) = (f32x4){vv[4], vv[5], vv[6], vv[7]}; } }
}

template <int NR>
__device__ __forceinline__ void postproj_rows_ck(const Ptrs& P, int l, const int (&rows)[NR], int lane) {
    unsigned cw[NR]; float kx1[NR], kx2[NR]; f32x2 cs[NR];
#pragma unroll
    for (int r = 0; r < NR; ++r) { if (rows[r] >= MP) continue; bf16* zr = (bf16*)(P.ws + WS_Z) + (size_t)rows[r] * ZW;
        cw[r] = *(const GAS unsigned*)(zr + 256 + 2 * lane); kx1[r] = 0.f; kx2[r] = 0.f; cs[r] = (f32x2){0.f, 0.f};
        if (lane < 16) { kx1[r] = bf2f(zr[384 + lane]); kx2[r] = bf2f(zr[400 + lane]); cs[r] = *(const f32x2*)((const float*)(P.ws + WS_ROPE) + (size_t)(rows[r] & (SEQ - 1)) * 32 + 2 * lane); } }
    const f32x2 g = *(const f32x2*)(P.kv_norm + l * KVL + 2 * lane);
#pragma unroll
    for (int r = 0; r < NR; ++r) { if (rows[r] >= MP) continue; bf16* zr = (bf16*)(P.ws + WS_Z) + (size_t)rows[r] * ZW;
        const float c0 = bflo(cw[r]), c1 = bfhi(cw[r]);
        const float rc = 1.0f / sqrtf(wave_sum(c0 * c0 + c1 * c1) * (1.f / KVL) + EPS);
        const float a = c0 * rc * g.x, b = c1 * rc * g.y;
        *(GAS unsigned*)(zr + 256 + 2 * lane) = pk2(a, b);
        *(GAS f32x2*)(P.out + O_CKV_P + ((size_t)l * MP + rows[r]) * KVL + 2 * lane) = (f32x2){a, b};
        if (lane < 16) { const float y1 = kx1[r] * cs[r].x - kx2[r] * cs[r].y, y2 = kx2[r] * cs[r].x + kx1[r] * cs[r].y;
            *(GAS unsigned*)(zr + 384 + 2 * lane) = pk2(y1, y2);
            float* op = P.out + O_KR_P + ((size_t)l * MP + rows[r]) * ROPE; op[lane] = y1; op[16 + lane] = y2; } }
}

struct RowIO { const float* xold; const bf16* xbold; const bf16* trow; const float* slab; float* xnew; bf16* xb; float* rs; };
template <int NR>
__device__ __forceinline__ void resid_rows(const RowIO (&io)[NR], const bool (&valid)[NR], const float* gpost, int lane) {
    float t[NR][16], x[NR][16];
#pragma unroll
    for (int r = 0; r < NR; ++r) if (valid[r]) {
#pragma unroll
        for (int jj = 0; jj < 2; ++jj) {
            const int c0 = jj * 512 + 8 * lane;
            if (io[r].trow) { const v4u w = __builtin_nontemporal_load((const GAS v4u*)(io[r].trow + c0));
                t[r][8 * jj + 0] = bflo(w.x); t[r][8 * jj + 1] = bfhi(w.x); t[r][8 * jj + 2] = bflo(w.y); t[r][8 * jj + 3] = bfhi(w.y);
                t[r][8 * jj + 4] = bflo(w.z); t[r][8 * jj + 5] = bfhi(w.z); t[r][8 * jj + 6] = bflo(w.w); t[r][8 * jj + 7] = bfhi(w.w);
            } else {
                f32x4 a = {0.f, 0.f, 0.f, 0.f}, b = {0.f, 0.f, 0.f, 0.f};
#pragma unroll
                for (int ks = 0; ks < 4; ++ks) { a += *(const GAS f32x4*)(io[r].slab + (size_t)ks * MS * DM + c0); b += *(const GAS f32x4*)(io[r].slab + (size_t)ks * MS * DM + c0 + 4); }
                t[r][8 * jj + 0] = a.x; t[r][8 * jj + 1] = a.y; t[r][8 * jj + 2] = a.z; t[r][8 * jj + 3] = a.w; t[r][8 * jj + 4] = b.x; t[r][8 * jj + 5] = b.y; t[r][8 * jj + 6] = b.z; t[r][8 * jj + 7] = b.w;
            }
            if (io[r].xold) { const f32x4 xa = __builtin_nontemporal_load((const GAS f32x4*)(io[r].xold + c0)), xb = __builtin_nontemporal_load((const GAS f32x4*)(io[r].xold + c0 + 4));
                x[r][8 * jj + 0] = xa.x; x[r][8 * jj + 1] = xa.y; x[r][8 * jj + 2] = xa.z; x[r][8 * jj + 3] = xa.w; x[r][8 * jj + 4] = xb.x; x[r][8 * jj + 5] = xb.y; x[r][8 * jj + 6] = xb.z; x[r][8 * jj + 7] = xb.w;
            } else { const v4u w = *(const GAS v4u*)(io[r].xbold + c0); const float inv = 1.0f / *(const GAS float*)io[r].rs;
                x[r][8 * jj + 0] = bflo(w.x) * inv; x[r][8 * jj + 1] = bfhi(w.x) * inv; x[r][8 * jj + 2] = bflo(w.y) * inv; x[r][8 * jj + 3] = bfhi(w.y) * inv;
                x[r][8 * jj + 4] = bflo(w.z) * inv; x[r][8 * jj + 5] = bfhi(w.z) * inv; x[r][8 * jj + 6] = bflo(w.w) * inv; x[r][8 * jj + 7] = bfhi(w.w) * inv; }
        }
    }
    float gp[16];
#pragma unroll
    for (int jj = 0; jj < 2; ++jj) { const int c0 = jj * 512 + 8 * lane;
        const f32x4 g0 = *(const f32x4*)(gpost + c0), g1 = *(const f32x4*)(gpost + c0 + 4); gp[8 * jj] = g0.x; gp[8 * jj + 1] = g0.y; gp[8 * jj + 2] = g0.z; gp[8 * jj + 3] = g0.w; gp[8 * jj + 4] = g1.x; gp[8 * jj + 5] = g1.y; gp[8 * jj + 6] = g1.z; gp[8 * jj + 7] = g1.w; }
#pragma unroll
    for (int r = 0; r < NR; ++r) if (valid[r]) {
        float s = 0.f;
#pragma unroll
        for (int e = 0; e < 16; ++e) s += t[r][e] * t[r][e];
        const float rstd = 1.0f / sqrtf(wave_sum(s) * (1.f / DM) + EPS);
        float s2 = 0.f;
#pragma unroll
        for (int e = 0; e < 16; ++e) { x[r][e] += t[r][e] * rstd * gp[e]; s2 += x[r][e] * x[r][e]; }
        if (io[r].xnew) {
#pragma unroll
            for (int jj = 0; jj < 2; ++jj) { const int c0 = jj * 512 + 8 * lane;
                __builtin_nontemporal_store((f32x4){x[r][8 * jj], x[r][8 * jj + 1], x[r][8 * jj + 2], x[r][8 * jj + 3]}, (GAS f32x4*)(io[r].xnew + c0));
                __builtin_nontemporal_store((f32x4){x[r][8 * jj + 4], x[r][8 * jj + 5], x[r][8 * jj + 6], x[r][8 * jj + 7]}, (GAS f32x4*)(io[r].xnew + c0 + 4)); } }
        if (io[r].xb) {
            const float r2 = 1.0f / sqrtf(wave_sum(s2) * (1.f / DM) + EPS);
            if (lane == 0) *io[r].rs = r2;
#pragma unroll
            for (int jj = 0; jj < 2; ++jj) { const int c0 = jj * 512 + 8 * lane;
                v4u o; o.x = pk2(x[r][8 * jj] * r2, x[r][8 * jj + 1] * r2); o.y = pk2(x[r][8 * jj + 2] * r2, x[r][8 * jj + 3] * r2); o.z = pk2(x[r][8 * jj + 4] * r2, x[r][8 * jj + 5] * r2); o.w = pk2(x[r][8 * jj + 6] * r2, x[r][8 * jj + 7] * r2);
                *(GAS v4u*)(io[r].xb + c0) = o; }
        }
    }
}

constexpr int AT_KSLOT = 12288, AT_VSLOT = 8192, AT_VOFF = 3 * AT_KSLOT, AT_LDS = AT_VOFF + 3 * AT_VSLOT;
__device__ __forceinline__ void glds16(const void* gsrc, unsigned lds_dst) { unsigned keep;
    asm volatile("s_mov_b32 %0, m0\n\ts_mov_b32 m0, %2\n\ts_nop 0\n\tglobal_load_lds_dwordx4 %1, off\n\ts_mov_b32 m0, %0" : "=&s"(keep) : "v"(gsrc), "s"(lds_dst) : "memory"); }
__device__ __forceinline__ float xhalf_max(float v) { auto rr = __builtin_amdgcn_permlane32_swap(__float_as_uint(v), __float_as_uint(v), false, false); return __builtin_fmaxf(__uint_as_float(rr[0]), __uint_as_float(rr[1])); }
__device__ __forceinline__ float xhalf_sum(float v) { auto rr = __builtin_amdgcn_permlane32_swap(__float_as_uint(v), __float_as_uint(v), false, false); return __uint_as_float(rr[0]) + __uint_as_float(rr[1]); }
typedef __attribute__((address_space(3))) const char* lds_cptr;
__device__ __forceinline__ void at_kload2(bf16x8* kf, lds_cptr kp, int j) { kf[2 * j] = *(const LAS bf16x8*)(kp + j * 2048); kf[2 * j + 1] = *(const LAS bf16x8*)(kp + j * 2048 + 512); }
__device__ __forceinline__ unsigned at_cvtpk(float lo, float hi) { typedef float f2 __attribute__((ext_vector_type(2))); typedef __bf16 b2 __attribute__((ext_vector_type(2))); f2 v = {lo, hi}; b2 b = __builtin_convertvector(v, b2); return __builtin_bit_cast(unsigned, b); }
#define AT_SBAR() __builtin_amdgcn_sched_barrier(0)
#define AT_WAIT_BAR(N) asm volatile("s_waitcnt vmcnt(" #N ") lgkmcnt(0)\n\ts_barrier" ::: "memory")
__device__ __forceinline__ void attn_unit(const Ptrs& P, int b, int h, int qb, LAS char* lds, int tid) {
    asm volatile("" : "+v"(tid));
    const int lane = tid & 63, wid = __builtin_amdgcn_readfirstlane(tid >> 6), r32 = lane & 31, hi = lane >> 5;
    const bf16* Qn = (const bf16*)(P.ws + WS_QN); const bf16* Qr = (const bf16*)(P.ws + WS_QR); const bf16* KV = (const bf16*)(P.ws + WS_KV); const bf16* Z = (const bf16*)(P.ws + WS_Z);
    bf16* AG = (bf16*)(P.ws + WS_AG);
    const size_t rowbase = (size_t)b * SEQ; const int q0 = qb * 256, qrel = wid * 32 + r32, qrow = q0 + qrel;
    const unsigned lds0 = (unsigned)(uintptr_t)lds;
    const bf16* ksrc1 = KV + (rowbase + lane) * 1024 + h * 64 + wid * 8;
    const bf16* ksrc2 = Z + (rowbase + lane) * ZW + 384 + (wid & 3) * 8;
    const bf16* vsrc = KV + (rowbase + 16 * (wid & 3) + (lane >> 2)) * 1024 + 512 + h * 64 + (wid >> 2) * 32 + (lane & 3) * 8;
    const unsigned kd1 = lds0 + wid * 1024, kd2 = lds0 + (8 + (wid & 3)) * 1024, vd = lds0 + AT_VOFF + wid * 1024;
#define DMA_K(t, slot) do { glds16(ksrc1 + (size_t)(t) * 64 * 1024, (unsigned)__builtin_amdgcn_readfirstlane(kd1 + (slot) * AT_KSLOT)); glds16(ksrc2 + (size_t)(t) * 64 * ZW, (unsigned)__builtin_amdgcn_readfirstlane(kd2 + (slot) * AT_KSLOT)); } while (0)
#define DMA_V(t, slot) glds16(vsrc + (size_t)(t) * 64 * 1024, (unsigned)__builtin_amdgcn_readfirstlane(vd + (slot) * AT_VSLOT))
    const lds_cptr kp0 = (lds_cptr)lds + hi * 1024 + r32 * 16;
    const lds_cptr vp0 = (lds_cptr)lds + AT_VOFF + ((lane >> 4) & 1) * 32 + (lane & 3) * 8 + (4 * hi + ((lane & 15) >> 2)) * 64;
    const int NT = (q0 + 256) / 64;
    DMA_K(0, 0); DMA_V(0, 0); DMA_K(1, 1); DMA_K(2, 2);
    bf16x8 qr[6];
#pragma unroll
    for (int s = 0; s < 4; ++s) qr[s] = *(const GAS bf16x8*)(Qn + (rowbase + qrow) * 512 + h * 64 + 16 * s + 8 * hi);
#pragma unroll
    for (int s = 0; s < 2; ++s) qr[4 + s] = *(const GAS bf16x8*)(Qr + (rowbase + qrow) * 256 + h * 32 + 16 * s + 8 * hi);
    asm volatile("s_waitcnt vmcnt(0)" : "+v"(qr[0]), "+v"(qr[1]), "+v"(qr[2]), "+v"(qr[3]), "+v"(qr[4]), "+v"(qr[5]) :: "memory");
    float mhat = 0.f, l_reg = 0.f; f32x16 o0 = {}, o1 = {};
    bf16x8 kf[12];
#define CMASK(C0, C1, tt) do { const int jb_ = (tt) - (NT - 4); if (jb_ >= 0) { const int kb_ = 64 * jb_ + 4 * hi; \
        _Pragma("unroll") for (int r = 0; r < 16; ++r) { const int kv = kb_ + (r & 3) + 8 * (r >> 2); if (kv > qrel) C0[r] = -INFINITY; if (kv + 32 > qrel) C1[r] = -INFINITY; } } } while (0)
#define ROWMAX(C0, C1, out) do { float a_ = __builtin_fmaxf(__builtin_fmaxf(C0[0], C0[1]), C1[0]), b_ = __builtin_fmaxf(__builtin_fmaxf(C0[2], C0[3]), C1[1]); a_ = __builtin_fmaxf(__builtin_fmaxf(a_, C1[2]), C1[3]); \
        _Pragma("unroll") for (int r = 4; r < 16; r += 4) { a_ = __builtin_fmaxf(__builtin_fmaxf(a_, C0[r]), C0[r + 1]); b_ = __builtin_fmaxf(__builtin_fmaxf(b_, C0[r + 2]), C0[r + 3]); \
            a_ = __builtin_fmaxf(__builtin_fmaxf(a_, C1[r]), C1[r + 1]); b_ = __builtin_fmaxf(__builtin_fmaxf(b_, C1[r + 2]), C1[r + 3]); } \
        out = xhalf_max(__builtin_fmaxf(a_, b_)); } while (0)
    f32x16 pA0, pA1, pB0, pB1;
    AT_WAIT_BAR(0);
    {
#pragma unroll
        for (int j = 0; j < 6; ++j) at_kload2(kf, kp0, j);
        pA0 = __builtin_amdgcn_mfma_f32_32x32x16_bf16(kf[0], qr[0], (f32x16){}, 0, 0, 0); pA1 = __builtin_amdgcn_mfma_f32_32x32x16_bf16(kf[1], qr[0], (f32x16){}, 0, 0, 0);
#pragma unroll
        for (int s = 1; s < 6; ++s) { pA0 = __builtin_amdgcn_mfma_f32_32x32x16_bf16(kf[2 * s], qr[s], pA0, 0, 0, 0); pA1 = __builtin_amdgcn_mfma_f32_32x32x16_bf16(kf[2 * s + 1], qr[s], pA1, 0, 0, 0); }
        CMASK(pA0, pA1, 0);
        float rm; ROWMAX(pA0, pA1, rm); mhat = rm;
#pragma unroll
        for (int r = 0; r < 16; ++r) { pA0[r] = __builtin_amdgcn_exp2f(pA0[r] - mhat); pA1[r] = __builtin_amdgcn_exp2f(pA1[r] - mhat); }
    }
    AT_WAIT_BAR(0);
    DMA_K(3, 0); DMA_V(1, 1);
#pragma unroll
    for (int j = 0; j < 6; ++j) at_kload2(kf, kp0 + AT_KSLOT, j);
    AT_WAIT_BAR(3);
    s16x4 vlo[8], vhi[8]; v4u pw0, pw1, pw2, pw3;
    bool resc = false; float fsc = 1.f;
#define PKW(Pt, B) at_cvtpk(Pt[B], Pt[B + 1])
#define PAF(k) __builtin_bit_cast(bf16x8, pw##k)
#define VFR(i) cat8(vlo[i], vhi[i])
#define PIN(x) asm volatile("" : "+v"(x))
#define VRD(i) do { vlo[i] = vtr(vp_ + (((i) >> 2) * 4096 + ((i) & 3) * 1024)); vhi[i] = vtr(vp_ + (((i) >> 2) * 4096 + ((i) & 3) * 1024 + 512)); } while (0)
#define GAPA(MF, A0, A1, A2, A3, W0, W1, PW) do { MF; sacc += A0; sacc += A1; sacc += A2; sacc += A3; PIN(sacc); W0; W1; PIN(PW); AT_SBAR(); } while (0)
#define EXM(v) __builtin_amdgcn_exp2f((v) - mhat)
#define GAPB(MF, X, B) do { MF; X[B] = EXM(X[B]); X[B + 1] = EXM(X[B + 1]); X[B + 2] = EXM(X[B + 2]); X[B + 3] = EXM(X[B + 3]); PIN(X); AT_SBAR(); } while (0)
#define KRD(G, j) do { if (G) { at_kload2(kf, kp0 + sl_next * AT_KSLOT, j); AT_SBAR(); } } while (0)
#define STEP(C0, C1, P0, P1, t, GK, GV, GL) do { AT_SBAR(); \
        const lds_cptr vp_ = vp0 + sl_prev * AT_VSLOT; \
        VRD(0); AT_SBAR(); float sacc = (P0[0] + P0[1]); \
        GAPA(C0 = __builtin_amdgcn_mfma_f32_32x32x16_bf16(kf[0], qr[0], (f32x16){}, 0, 0, 0), P0[2], P0[3], P0[4], P0[5],     pw0[0] = PKW(P0, 0), pw0[1] = PKW(P0, 2), pw0); \
        VRD(4); AT_SBAR(); GAPA(C1 = __builtin_amdgcn_mfma_f32_32x32x16_bf16(kf[1], qr[0], (f32x16){}, 0, 0, 0), P0[6], P0[7], P0[8], P0[9],     pw0[2] = PKW(P0, 4), pw0[3] = PKW(P0, 6), pw0); \
        VRD(1); AT_SBAR(); GAPA(C0 = __builtin_amdgcn_mfma_f32_32x32x16_bf16(kf[2], qr[1], C0, 0, 0, 0),   P0[10], P0[11], P0[12], P0[13], pw1[0] = PKW(P0, 8), pw1[1] = PKW(P0, 10), pw1); \
        VRD(5); AT_SBAR(); GAPA(C1 = __builtin_amdgcn_mfma_f32_32x32x16_bf16(kf[3], qr[1], C1, 0, 0, 0),   P0[14], P0[15], P1[0], P1[1],   pw1[2] = PKW(P0, 12), pw1[3] = PKW(P0, 14), pw1); \
        VRD(2); AT_SBAR(); GAPA(C0 = __builtin_amdgcn_mfma_f32_32x32x16_bf16(kf[4], qr[2], C0, 0, 0, 0),   P1[2], P1[3], P1[4], P1[5],     pw2[0] = PKW(P1, 0), pw2[1] = PKW(P1, 2), pw2); \
        VRD(6); AT_SBAR(); GAPA(C1 = __builtin_amdgcn_mfma_f32_32x32x16_bf16(kf[5], qr[2], C1, 0, 0, 0),   P1[6], P1[7], P1[8], P1[9],     pw2[2] = PKW(P1, 4), pw2[3] = PKW(P1, 6), pw2); \
        VRD(3); AT_SBAR(); GAPA(C0 = __builtin_amdgcn_mfma_f32_32x32x16_bf16(kf[6], qr[3], C0, 0, 0, 0),   P1[10], P1[11], P1[12], P1[13], pw3[0] = PKW(P1, 8), pw3[1] = PKW(P1, 10), pw3); \
        VRD(7); AT_SBAR(); GAPA(C1 = __builtin_amdgcn_mfma_f32_32x32x16_bf16(kf[7], qr[3], C1, 0, 0, 0),   P1[14], P1[15], 0.f, 0.f,       pw3[2] = PKW(P1, 12), pw3[3] = PKW(P1, 14), pw3); \
        C0 = __builtin_amdgcn_mfma_f32_32x32x16_bf16(kf[8], qr[4], C0, 0, 0, 0); C1 = __builtin_amdgcn_mfma_f32_32x32x16_bf16(kf[9], qr[4], C1, 0, 0, 0); \
        C0 = __builtin_amdgcn_mfma_f32_32x32x16_bf16(kf[10], qr[5], C0, 0, 0, 0); C1 = __builtin_amdgcn_mfma_f32_32x32x16_bf16(kf[11], qr[5], C1, 0, 0, 0); \
        l_reg += sacc; \
        if (GK) { DMA_K((t) + 3, sl_cur); } if (GV) { DMA_V((t) + 1, sl_next); } \
        CMASK(C0, C1, t); \
        { float rm; ROWMAX(C0, C1, rm); resc = false; \
          if (__builtin_expect(__any(rm - mhat > 8.0f), 0)) { const float nm = __builtin_fmaxf(rm, mhat); fsc = __builtin_amdgcn_exp2f(mhat - nm); mhat = nm; l_reg *= fsc; resc = true; } } \
        AT_SBAR(); \
        GAPB(o0 = __builtin_amdgcn_mfma_f32_32x32x16_bf16(VFR(0), PAF(0), o0, 0, 0, 0), C0, 0); \
        GAPB(o1 = __builtin_amdgcn_mfma_f32_32x32x16_bf16(VFR(4), PAF(0), o1, 0, 0, 0), C0, 4); \
        KRD(GL, 0); GAPB(o0 = __builtin_amdgcn_mfma_f32_32x32x16_bf16(VFR(1), PAF(1), o0, 0, 0, 0), C0, 8); \
        KRD(GL, 1); GAPB(o1 = __builtin_amdgcn_mfma_f32_32x32x16_bf16(VFR(5), PAF(1), o1, 0, 0, 0), C0, 12); \
        KRD(GL, 2); GAPB(o0 = __builtin_amdgcn_mfma_f32_32x32x16_bf16(VFR(2), PAF(2), o0, 0, 0, 0), C1, 0); \
        KRD(GL, 3); GAPB(o1 = __builtin_amdgcn_mfma_f32_32x32x16_bf16(VFR(6), PAF(2), o1, 0, 0, 0), C1, 4); \
        KRD(GL, 4); GAPB(o0 = __builtin_amdgcn_mfma_f32_32x32x16_bf16(VFR(3), PAF(3), o0, 0, 0, 0), C1, 8); \
        KRD(GL, 5); GAPB(o1 = __builtin_amdgcn_mfma_f32_32x32x16_bf16(VFR(7), PAF(3), o1, 0, 0, 0), C1, 12); \
    } while (0)
#define RESC() do { if (resc) { _Pragma("unroll") for (int r = 0; r < 16; ++r) { o0[r] *= fsc; o1[r] *= fsc; } } } while (0)
    int sl_prev = 0, sl_cur = 1, sl_next = 2;
#define ROT() do { sl_prev = sl_cur; sl_cur = sl_next; sl_next = (sl_next == 2) ? 0 : sl_next + 1; } while (0)
#define ENDW(tt) do { if ((tt) + 3 < NT) { AT_WAIT_BAR(3); } else if ((tt) + 2 < NT) { AT_WAIT_BAR(1); } else { AT_WAIT_BAR(0); } } while (0)
    int t = 1;
    for (; t + 1 < NT; t += 2) {
        STEP(pB0, pB1, pA0, pA1, t, (t + 3 < NT), (t + 1 < NT), (t + 1 < NT));         ENDW(t);     RESC(); ROT();
        STEP(pA0, pA1, pB0, pB1, t + 1, (t + 4 < NT), (t + 2 < NT), (t + 2 < NT));     ENDW(t + 1); RESC(); ROT();
    }
    STEP(pB0, pB1, pA0, pA1, NT - 1, false, false, false); RESC();
    { float sacc = 0.f;
#pragma unroll
      for (int r = 0; r < 16; ++r) sacc += pB0[r] + pB1[r];
      l_reg += sacc;
      const lds_cptr vp_ = vp0 + sl_cur * AT_VSLOT;
#pragma unroll
      for (int ks = 0; ks < 4; ++ks) { const f32x16& pp = (ks >> 1) ? pB1 : pB0; const int s2 = ks & 1;
          const bf16x8 pf = pack8(pp[8 * s2], pp[8 * s2 + 1], pp[8 * s2 + 2], pp[8 * s2 + 3], pp[8 * s2 + 4], pp[8 * s2 + 5], pp[8 * s2 + 6], pp[8 * s2 + 7]);
          const lds_cptr vb = vp_ + ks * 1024;
          const bf16x8 v0 = cat8(vtr(vb), vtr(vb + 512)), v1 = cat8(vtr(vb + 4096), vtr(vb + 4096 + 512));
          o0 = __builtin_amdgcn_mfma_f32_32x32x16_bf16(v0, pf, o0, 0, 0, 0); o1 = __builtin_amdgcn_mfma_f32_32x32x16_bf16(v1, pf, o1, 0, 0, 0); } }
#undef DMA_K
#undef DMA_V
#undef CMASK
#undef ROWMAX
#undef PKW
#undef PAF
#undef VFR
#undef PIN
#undef VRD
#undef GAPA
#undef EXM
#undef GAPB
#undef KRD
#undef STEP
#undef RESC
#undef ROT
#undef ENDW
    l_reg = xhalf_sum(l_reg);
    const float rl = 1.0f / l_reg;
    bf16* orow = AG + (rowbase + qrow) * 1024 + h * 64;
#pragma unroll
    for (int q = 0; q < 4; ++q) { v2u w; w.x = pk2(o0[4 * q] * rl, o0[4 * q + 1] * rl); w.y = pk2(o0[4 * q + 2] * rl, o0[4 * q + 3] * rl); *(GAS v2u*)(orow + 8 * q + 4 * hi) = w;
        v2u w1; w1.x = pk2(o1[4 * q] * rl, o1[4 * q + 1] * rl); w1.y = pk2(o1[4 * q + 2] * rl, o1[4 * q + 3] * rl); *(GAS v2u*)(orow + 32 + 8 * q + 4 * hi) = w1; }
    asm volatile("s_waitcnt lgkmcnt(0)\n\ts_barrier" ::: "memory");
}

constexpr int MG_SLOT = 24576, MG_BOFF = 16384;
template <class Epi>
__device__ __forceinline__ void mid_gemm(const bf16* A, int lda, const bf16* Bt, int ldb, int Kper, int ntn, int KS, const Epi& E, int bx, int G, LAS char* lds, int tid) {
    asm volatile("" : "+v"(tid));
    const int lane = tid & 63, wid = __builtin_amdgcn_readfirstlane(tid >> 6), r32 = lane & 31, hi = lane >> 5, mb = wid & 3, nb = wid >> 2;
    const unsigned lds0 = (unsigned)(uintptr_t)lds;
    const int nitem = 4 * ntn * KS, nk = Kper / 64;
    for (int item = bx; item < nitem; item += G) {
        const int tm = item & 3, rest = item >> 2, tn = rest % ntn, ks = rest / ntn;
        const bf16* a0 = A + (size_t)(tm * 128 + (wid & 1) * 64 + lane) * lda + ks * Kper + (wid >> 1) * 8;
        const bf16* a1 = a0 + 32;
        const bf16* b0 = Bt + (size_t)(tn * 64 + lane) * ldb + ks * Kper + wid * 8;
        const unsigned da0 = lds0 + (wid >> 1) * 2048 + (wid & 1) * 1024, da1 = da0 + 4 * 2048, db0 = lds0 + MG_BOFF + wid * 1024;
#define MG_ISSUE(t, so) do { glds16(a0 + (t) * 64, (unsigned)__builtin_amdgcn_readfirstlane(da0 + (so))); glds16(a1 + (t) * 64, (unsigned)__builtin_amdgcn_readfirstlane(da1 + (so))); \
                             glds16(b0 + (t) * 64, (unsigned)__builtin_amdgcn_readfirstlane(db0 + (so))); } while (0)
        __syncthreads();
        MG_ISSUE(0, 0); if (nk > 1) MG_ISSUE(1, MG_SLOT);
        f32x16 acc = {}, acc2 = {};
        const LAS char* ap = lds + hi * 2048 + (mb * 32 + r32) * 16;
        const LAS char* bp = lds + MG_BOFF + hi * 1024 + (nb * 32 + r32) * 16;
        int sc = 0, s2 = 2 * MG_SLOT;
        for (int t = 0; t < nk; ++t) {
            if (t + 1 < nk) asm volatile("s_waitcnt vmcnt(3)\n\ts_barrier" ::: "memory"); else asm volatile("s_waitcnt vmcnt(0)\n\ts_barrier" ::: "memory");
            if (t + 2 < nk) MG_ISSUE(t + 2, s2);
#pragma unroll
            for (int s = 0; s < 4; ++s) { const bf16x8 af = *(const LAS bf16x8*)(ap + sc + s * 4096), bfr = *(const LAS bf16x8*)(bp + sc + s * 2048);
                if (s & 1) acc2 = __builtin_amdgcn_mfma_f32_32x32x16_bf16(bfr, af, acc2, 0, 0, 0); else acc = __builtin_amdgcn_mfma_f32_32x32x16_bf16(bfr, af, acc, 0, 0, 0); }
            sc = (sc == 2 * MG_SLOT) ? 0 : sc + MG_SLOT; s2 = (s2 == 2 * MG_SLOT) ? 0 : s2 + MG_SLOT;
        }
#undef MG_ISSUE
        acc += acc2;
        E(acc, tm * 128 + mb * 32 + r32, tn * 64 + nb * 32, ks, hi);
        asm volatile("s_waitcnt lgkmcnt(0)\n\ts_barrier" ::: "memory");
    }
}

constexpr int G_PITCH = 528;
__device__ __forceinline__ void gate_unit(const Ptrs& P, int l, int chunk, LAS char* lds, int tid) {
    asm volatile("" : "+v"(tid));
    const int lane = tid & 63, wid = __builtin_amdgcn_readfirstlane(tid >> 6), r32 = lane & 31, hi = lane >> 5;
    const bf16* Z = (const bf16*)(P.ws + WS_Z); bf16* AG = (bf16*)(P.ws + WS_AG);
    const bf16* Wsp = (const bf16*)(P.ws + WS_WL + (size_t)l * WL_STRIDE + WL_WSP);
    const size_t row0 = (size_t)chunk * CHUNK;
    const int iblk = wid >> 1, dblk = wid & 1, nsteps = 2 * (iblk + 1);
    const size_t irow = row0 + iblk * 32 + r32;
    for (int pass = 0; pass < 2; ++pass) {
        __syncthreads();
#pragma unroll
        for (int i = 0; i < 8; ++i) { const int c = tid + 512 * i, j = c >> 5, ch = c & 31; const v4u vv = *(const GAS v4u*)(Z + (row0 + j) * ZW + 1024 + pass * 256 + ch * 8);
            const float* sp = (const float*)(P.ws + WS_SSV) + (row0 + j) * 8; const f32x4 s0 = *(const GAS f32x4*)sp, s1 = *(const GAS f32x4*)(sp + 4);
            const float rv = 1.0f / sqrtf((((s0.x + s0.y) + (s0.z + s0.w)) + ((s1.x + s1.y) + (s1.z + s1.w))) * (1.f / GMW) + EPS);
            const float* gp = P.v_norm + l * GMW + pass * 256 + ch * 8; const f32x4 g0 = *(const f32x4*)gp, g1 = *(const f32x4*)(gp + 4);
            v4u o; o.x = pk2(bflo(vv.x) * rv * g0.x, bfhi(vv.x) * rv * g0.y); o.y = pk2(bflo(vv.y) * rv * g0.z, bfhi(vv.y) * rv * g0.w);
            o.z = pk2(bflo(vv.z) * rv * g1.x, bfhi(vv.z) * rv * g1.y); o.w = pk2(bflo(vv.w) * rv * g1.z, bfhi(vv.w) * rv * g1.w);
            *(LAS v4u*)(lds + j * G_PITCH + ch * 16) = o; }
        __syncthreads();
        bf16x8 a[8], an[8]; v2u uu[4], un[4]; float bsv, bsn;
#define G_LOAD(A_, U_, B_, g_) do { _Pragma("unroll") for (int s = 0; s < 8; ++s) A_[s] = *(const GAS bf16x8*)(Wsp + ((size_t)(g_) * 128 + iblk * 32 + r32) * 128 + 16 * s + 8 * hi); \
            B_ = P.b_sp[((size_t)l * 8 + (g_)) * 128 + iblk * 32 + r32]; \
            _Pragma("unroll") for (int q = 0; q < 4; ++q) U_[q] = *(const GAS v2u*)(Z + irow * ZW + 512 + (g_) * 64 + dblk * 32 + 8 * q + 4 * hi); } while (0)
        G_LOAD(a, uu, bsv, pass * 4);
#pragma unroll
        for (int gg = 0; gg < 4; ++gg) {
            const int g = pass * 4 + gg;
            if (gg < 3) G_LOAD(an, un, bsn, g + 1);
            f32x16 acc = {};
            const LAS char* vb0 = lds + (8 * hi + ((lane & 15) >> 2)) * G_PITCH + (gg * 64 + dblk * 32 + 16 * ((lane >> 4) & 1) + 4 * (lane & 3)) * 2;
#pragma unroll
            for (int s = 0; s < 8; ++s) if (s < nsteps) {
                const LAS char* vb = vb0 + 16 * s * G_PITCH;
                const bf16x8 bb = cat8(vtr(vb), vtr(vb + 4 * G_PITCH));
                acc = __builtin_amdgcn_mfma_f32_32x32x16_bf16(bb, a[s], acc, 0, 0, 0);
            }
            bf16* op = AG + irow * 1024 + 512 + g * 64 + dblk * 32 + 4 * hi;
#pragma unroll
            for (int q = 0; q < 4; ++q) { const float u0 = bflo(uu[q].x), u1 = bfhi(uu[q].x), u2 = bflo(uu[q].y), u3 = bfhi(uu[q].y);
                v2u w; w.x = pk2(u0 * (acc[4 * q] + bsv), u1 * (acc[4 * q + 1] + bsv)); w.y = pk2(u2 * (acc[4 * q + 2] + bsv), u3 * (acc[4 * q + 3] + bsv));
                *(GAS v2u*)(op + 8 * q) = w; }
            if (gg < 3) {
#pragma unroll
                for (int s = 0; s < 8; ++s) a[s] = an[s];
#pragma unroll
                for (int q = 0; q < 4; ++q) uu[q] = un[q];
                bsv = bsn; }
        }
#undef G_LOAD
    }
    __syncthreads();
}

constexpr int SV_PITCH = 336, SV_WAVE = 32 * SV_PITCH, SQ_BYTES = 10240;
#define SGLD(dst, ptr, off) asm volatile("global_load_dwordx4 %0, %1, off offset:" #off " nt" : "=&v"(dst) : "v"(ptr) : "memory")
__device__ __forceinline__ void sample_unit(const Ptrs& P, int l, int b, LAS char* lds, int tid) {
    asm volatile("" : "+v"(tid));
    const int lane = tid & 63, wid = __builtin_amdgcn_readfirstlane(tid >> 6), r32 = lane & 31, hi = lane >> 5;
    const bf16* Qs = (const bf16*)(P.ws + WS_QS); const bf16* Z = (const bf16*)(P.ws + WS_Z); bf16* AG = (bf16*)(P.ws + WS_AG);
    __syncthreads();
    for (int idx = tid; idx < 640; idx += 512) { const int s = idx >> 6, ln = idx & 63, q = ln & 31, h8 = ln >> 5; const int qt = q >> 3, qh = q & 7;
        const bf16* src = Qs + ((size_t)b * 4 + qt) * 1280 + (s < 8 ? qh * 128 + 16 * s : 1024 + qh * 32 + 16 * (s - 8)) + 8 * h8;
        *(LAS v4u*)(lds + idx * 16) = *(const GAS v4u*)src; }
    const int qt = r32 >> 3;
    f32x16 o[4];
#pragma unroll
    for (int cb = 0; cb < 4; ++cb) o[cb] = (f32x16){};
    float mrun = -1e30f, lrun = 0.f;
    LAS char* vimg = lds + SQ_BYTES + wid * SV_WAVE;
    const float* cc = P.cache_c + (size_t)l * NPHYS * PAGE * KVL; const float* cr = P.cache_r + (size_t)l * NPHYS * PAGE * ROPE;
    const int pgv = P.ptab[b * NPAGES + lane];
    __syncthreads();
    const int ntile = 32 + (wid == 0 ? 1 : 0);
    f32x4 raw[20];
#define S_ISSUE(it_) do { const int it__ = (it_); \
        if (it__ < 32) { const int ph0 = __shfl(pgv, 2 * it__), ph1 = __shfl(pgv, 2 * it__ + 1); \
            const float* kc0 = cc + ((size_t)ph0 * PAGE + 16 * wid + (lane >> 5)) * KVL + (lane & 31) * 4; const float* kc1 = cc + ((size_t)ph1 * PAGE + 16 * wid + (lane >> 5)) * KVL + (lane & 31) * 4; \
            const float* kr0 = cr + ((size_t)ph0 * PAGE + 16 * wid + (lane >> 3)) * ROPE + (lane & 7) * 4; const float* kr1 = cr + ((size_t)ph1 * PAGE + 16 * wid + (lane >> 3)) * ROPE + (lane & 7) * 4; \
            _Pragma("unroll") for (int j = 0; j < 8; ++j) { const float* pp = kc0 + (size_t)(2 * j) * KVL; SGLD(raw[j], pp, 0); } \
            _Pragma("unroll") for (int j = 0; j < 8; ++j) { const float* pp = kc1 + (size_t)(2 * j) * KVL; SGLD(raw[8 + j], pp, 0); } \
            _Pragma("unroll") for (int j = 0; j < 2; ++j) { const float* pp = kr0 + (size_t)(8 * j) * ROPE; SGLD(raw[16 + j], pp, 0); } \
            _Pragma("unroll") for (int j = 0; j < 2; ++j) { const float* pp = kr1 + (size_t)(8 * j) * ROPE; SGLD(raw[18 + j], pp, 0); } \
        } else { const float* kc = P.out + O_CKV_S + ((size_t)l * MS + b * 4) * KVL + (lane & 31) * 4; const float* kr = P.out + O_KR_S + ((size_t)l * MS + b * 4) * ROPE + (lane & 7) * 4; \
            _Pragma("unroll") for (int j = 0; j < 16; ++j) { const float* pp = kc + (size_t)((2 * j + (lane >> 5)) & 3) * KVL; SGLD(raw[j], pp, 0); } \
            _Pragma("unroll") for (int j = 0; j < 4; ++j) { const float* pp = kr + (size_t)((8 * j + (lane >> 3)) & 3) * ROPE; SGLD(raw[16 + j], pp, 0); } } } while (0)
    S_ISSUE(0);
    for (int it = 0; it < ntile; ++it) {
        asm volatile("s_waitcnt vmcnt(0)" : "+v"(raw[0]), "+v"(raw[1]), "+v"(raw[2]), "+v"(raw[3]), "+v"(raw[4]), "+v"(raw[5]), "+v"(raw[6]), "+v"(raw[7]), "+v"(raw[8]), "+v"(raw[9]),
                     "+v"(raw[10]), "+v"(raw[11]), "+v"(raw[12]), "+v"(raw[13]), "+v"(raw[14]), "+v"(raw[15]), "+v"(raw[16]), "+v"(raw[17]), "+v"(raw[18]), "+v"(raw[19]) :: "memory");
#pragma unroll
        for (int j = 0; j < 16; ++j) { v2u w; w.x = pg8::cvt_pk_bf16(raw[j].x, raw[j].y); w.y = pg8::cvt_pk_bf16(raw[j].z, raw[j].w); *(LAS v2u*)(vimg + (2 * j + (lane >> 5)) * SV_PITCH + (lane & 31) * 8) = w; }
#pragma unroll
        for (int j = 0; j < 4; ++j) { v2u w; w.x = pg8::cvt_pk_bf16(raw[16 + j].x, raw[16 + j].y); w.y = pg8::cvt_pk_bf16(raw[16 + j].z, raw[16 + j].w); *(LAS v2u*)(vimg + (8 * j + (lane >> 3)) * SV_PITCH + 256 + (lane & 7) * 8) = w; }
        const bool newt = it >= 32;
        if (it + 1 < ntile) S_ISSUE(it + 1);
        LDS_WAIT();
        f32x16 p = {};
#pragma unroll 2
        for (int s = 0; s < 10; ++s) { const bf16x8 kf = *(const LAS bf16x8*)(vimg + r32 * SV_PITCH + (16 * s + 8 * hi) * 2), qf = *(const LAS bf16x8*)(lds + (s * 64 + lane) * 16);
            p = __builtin_amdgcn_mfma_f32_32x32x16_bf16(kf, qf, p, 0, 0, 0); }
        if (newt) {
#pragma unroll
            for (int r = 0; r < 16; ++r) { const int key = crow(r, hi); if (key > qt) p[r] = -INFINITY; }
        }
        float mx = p[0];
#pragma unroll
        for (int r = 1; r < 16; ++r) mx = fmaxf(mx, p[r]);
        mx = fmaxf(mx, __shfl_xor(mx, 32));
        const float mnew = fmaxf(mrun, mx), alpha = __builtin_amdgcn_exp2f(mrun - mnew); mrun = mnew;
        float ps = 0.f;
#pragma unroll
        for (int r = 0; r < 16; ++r) { p[r] = __builtin_amdgcn_exp2f(p[r] - mnew); ps += p[r]; }
        lrun = lrun * alpha + ps;
#pragma unroll
        for (int cb = 0; cb < 4; ++cb)
#pragma unroll
            for (int r = 0; r < 16; ++r) o[cb][r] *= alpha;
        LDS_WAIT();
#pragma unroll
        for (int s2 = 0; s2 < 2; ++s2) {
            const bf16x8 pf = pack8(p[8 * s2], p[8 * s2 + 1], p[8 * s2 + 2], p[8 * s2 + 3], p[8 * s2 + 4], p[8 * s2 + 5], p[8 * s2 + 6], p[8 * s2 + 7]);
            const LAS char* vb = vimg + (16 * s2 + 4 * hi + ((lane & 15) >> 2)) * SV_PITCH + (16 * ((lane >> 4) & 1) + 4 * (lane & 3)) * 2;
#pragma unroll
            for (int cb = 0; cb < 4; ++cb) { const bf16x8 vf = cat8(vtr(vb + cb * 64), vtr(vb + cb * 64 + 8 * SV_PITCH)); o[cb] = __builtin_amdgcn_mfma_f32_32x32x16_bf16(vf, pf, o[cb], 0, 0, 0); }
        }
        LDS_WAIT();
    }
#undef S_ISSUE
    lrun += __shfl_xor(lrun, 32);
    __syncthreads();
    LAS float* ost = (LAS float*)lds; LAS float* mst = (LAS float*)(lds + 132096); LAS float* lst = mst + 256;
#pragma unroll
    for (int cb = 0; cb < 4; ++cb)
#pragma unroll
        for (int r = 0; r < 16; ++r) ost[(wid * 128 + cb * 32 + crow(r, hi)) * 32 + r32] = o[cb][r];
    if (hi == 0) { mst[wid * 32 + r32] = mrun; lst[wid * 32 + r32] = lrun; }
    __syncthreads();
    {
        const int q = tid >> 4, c0 = (tid & 15) * 8;
        float mm = mst[q];
#pragma unroll
        for (int w = 1; w < 8; ++w) mm = fmaxf(mm, mst[w * 32 + q]);
        float sc[8], lt = 0.f;
#pragma unroll
        for (int w = 0; w < 8; ++w) { sc[w] = __builtin_amdgcn_exp2f(mst[w * 32 + q] - mm); lt += lst[w * 32 + q] * sc[w]; }
        const float rl = 1.0f / lt;
        float ol[8];
#pragma unroll
        for (int e = 0; e < 8; ++e) { float a = 0.f;
#pragma unroll
            for (int w = 0; w < 8; ++w) a += ost[(w * 128 + c0 + e) * 32 + q] * sc[w];
            ol[e] = a * rl; }
        __syncthreads();
        LAS float* olat = (LAS float*)lds;
#pragma unroll
        for (int e = 0; e < 8; ++e) olat[q * 128 + c0 + e] = ol[e];
    }
    __syncthreads();
    {
        const LAS float* olat = (const LAS float*)lds;
        const int q = tid >> 4, v0 = (tid & 15) * 4, h = q & 7, t = q >> 3;
        const float* wv = P.w_uv + (size_t)l * KVL * 512 + h * 64 + v0;
        f32x4 a = {0.f, 0.f, 0.f, 0.f};
#pragma unroll 32
        for (int c = 0; c < 128; ++c) { const f32x4 w = *(const GAS f32x4*)(wv + (size_t)c * 512); a += w * olat[q * 128 + c]; }
        v2u w; w.x = pk2(a.x, a.y); w.y = pk2(a.z, a.w);
        *(GAS v2u*)(AG + ((size_t)MP + b * 4 + t) * 1024 + h * 64 + v0) = w;
    }
    {
        const int col = tid, g = col >> 6;
        float vn[4], uu[4];
#pragma unroll
        for (int t = 0; t < 4; ++t) { vn[t] = bf2f(Z[((size_t)MP + b * 4 + t) * ZW + 1024 + col]); uu[t] = bf2f(Z[((size_t)MP + b * 4 + t) * ZW + 512 + col]); }
        const float* ws = P.w_sp + ((size_t)l * 8 + g) * 128 * 128; const float* bs = P.b_sp + ((size_t)l * 8 + g) * 128;
#pragma unroll
        for (int t = 0; t < 4; ++t) { float a = bs[t];
#pragma unroll
            for (int j = 0; j <= t; ++j) a += ws[t * 128 + j] * vn[j];
            AG[((size_t)MP + b * 4 + t) * 1024 + 512 + col] = (bf16)f2bf(uu[t] * a); }
    }
    __syncthreads();
}
constexpr int NWAVES = 8;
#ifndef NO_SAMPLE
#define NO_SAMPLE 0
#endif
#ifndef NO_ATTN
#define NO_ATTN 0
#endif
#ifndef NO_GATE
#define NO_GATE 0
#endif
#ifndef QPER
#define QPER 4
#endif
#ifndef PH_MASK
#define PH_MASK 0x3ff
#endif
#define PHEN(k) (((PH_MASK) >> (k)) & 1)
#ifndef PH_DOUBLE
#define PH_DOUBLE 0
#endif
#define PHREP(k) (1 + (((PH_DOUBLE) >> (k)) & 1))
constexpr int N_PHASES = 1 + 9 * DEPTH;
struct Args { Ptrs p; int ph_lo, ph_hi, one_launch, pad; };

__global__ void __launch_bounds__(NWAVES * 64, 2) fwd(Args args) {
    extern __shared__ __attribute__((aligned(16))) unsigned char lds_raw[];
    LAS unsigned char* lds = (LAS unsigned char*)lds_raw;
    const Ptrs& P = args.p;
    const int tid = threadIdx.x;
    const int G = gridDim.x; const int bx = blockIdx.x; const int vcu = (G % 8 == 0) ? (bx % 8) * (G / 8) + bx / 8 : bx;
    const int NGW = G * NWAVES;
    gu32* ctl = (gu32*)(P.ws + WS_CTL);
    for (int u = tid; u < (LDS_BYTES - LDSCTL_OFF) / 4; u += NWAVES * 64) ((LAS unsigned*)(lds + LDSCTL_OFF))[u] = 0u;
    __syncthreads();
    XcdBarrier bar; bar.bar = (unsigned*)(ctl + CW_BAR); bar.x = 0; bar.st = nullptr;
    if (args.one_launch) bar = xcd_barrier_post((unsigned*)(ctl + CW_BAR), (volatile LAS unsigned*)(lds + MISC_OFF) + 8);
    const int lo = args.ph_lo, hi_ = args.ph_hi;
#define IN(k) (lo <= (k) && (k) < hi_)
#ifndef PROBE_PHASE
#define PROBE_PHASE (-1)
#endif
#ifndef PROBE_MULT
#define PROBE_MULT 8
#endif
    unsigned long long pr_prev = 0ull, pr_acc = 0ull;
    if (PROBE_PHASE >= 0 && bx == 0) pr_prev = __builtin_amdgcn_s_memrealtime();
#define SEAM(k) do { if (IN(k) && IN((k) + 1)) { xcd_barrier(bar); for (int rb_ = 1; rb_ < PHREP(14); ++rb_) xcd_barrier(bar); } \
        if (PROBE_PHASE >= 0 && bx == 0) { const unsigned long long now_ = __builtin_amdgcn_s_memrealtime(); if ((k) == PROBE_PHASE) pr_acc += now_ - pr_prev; pr_prev = now_; } } while (0)

    bf16* Hb = (bf16*)(P.ws + WS_H); bf16* Zb = (bf16*)(P.ws + WS_Z); bf16* AGb = (bf16*)(P.ws + WS_AG); bf16* MIXb = (bf16*)(P.ws + WS_MIX); bf16* Rb = (bf16*)(P.ws + WS_R);
    float* FSb = (float*)(P.ws + WS_FS); float* RSb = (float*)(P.ws + WS_RS);
    const float* ropet = (const float*)(P.ws + WS_ROPE);

    for (int rep_ = 0; rep_ < PHREP(0); ++rep_) if (PHEN(0) && IN(0)) {
            int ptid = threadIdx.x; asm volatile("" : "+v"(ptid)); const int lane = ptid & 63, wave = __builtin_amdgcn_readfirstlane(ptid >> 6), gw = vcu * NWAVES + wave; (void)lane; (void)gw;
        LAS float* scr = (LAS float*)(lds + RING_OFF + wave * 16384);
        constexpr int I_IN = (DM / 64) * ((INW / 32 + 3) / 4), I_UQ = (QL / 64) * (768 / 128), I_UK = (KVL / 64) * (512 / 128), I_OUT = (DM / 64) * (DM / 128), I_UP = (DM / 64) * (DFF / 128), I_DN = (DFF / 64) * (DM / 128);
        constexpr int I_PAD = 96, I_QA = 1024, I_SP = 256;
        constexpr int PER_L = I_IN + I_UQ + 2 * I_UK + I_OUT + I_UP + I_DN + I_PAD + I_QA + I_SP;
        int it0 = gw, m0 = gw;
        while (it0 < DEPTH * PER_L || m0 < M) {
          if (it0 < DEPTH * PER_L) {
            const int l = it0 / PER_L; int r = it0 - l * PER_L; it0 += NGW;
            unsigned char* wl = P.ws + WS_WL + (size_t)l * WL_STRIDE;
            if (r < I_IN) { p0_transpose_item<1>(P.w_in + (size_t)l * DM * INW, DM, INW, (bf16*)(wl + WL_WIN), 0, scr, r, lane, P.nm_pre + l * DM); }
            else if ((r -= I_IN) < I_UQ) { p0_transpose_item<2>(P.w_uq + (size_t)l * QL * 768, QL, 768, (bf16*)(wl + WL_WUQ), 0, scr, r, lane, P.q_norm + l * QL); }
            else if ((r -= I_UQ) < I_UK) { p0_transpose_item<0>(P.w_uk + (size_t)l * KVL * 512, KVL, 512, (bf16*)(wl + WL_WKV), 0, scr, r, lane); }
            else if ((r -= I_UK) < I_UK) { p0_transpose_item<0>(P.w_uv + (size_t)l * KVL * 512, KVL, 512, (bf16*)(wl + WL_WKV), 512, scr, r, lane); }
            else if ((r -= I_UK) < I_OUT) { p0_transpose_item<0>(P.w_out + (size_t)l * DM * DM, DM, DM, (bf16*)(wl + WL_WOUT), 0, scr, r, lane); }
            else if ((r -= I_OUT) < I_UP) { p0_transpose_item<0>(P.w_up + (size_t)l * DM * DFF, DM, DFF, (bf16*)(wl + WL_WUP), 0, scr, r, lane, P.nf_pre + l * DM); }
            else if ((r -= I_UP) < I_DN) { p0_transpose_item<0>(P.w_dn + (size_t)l * DFF * DM, DFF, DM, (bf16*)(wl + WL_WDN), 0, scr, r, lane); }
            else if ((r -= I_DN) < I_PAD) {
                bf16* d = (bf16*)(wl + WL_WIN) + (size_t)(416 + r) * DM;
#pragma unroll
                for (int j = 0; j < 2; ++j) *(GAS v4u*)(d + j * 512 + 8 * lane) = (v4u){0u, 0u, 0u, 0u}; }
            else if ((r -= I_PAD) < I_QA) {
                const int h = r >> 7, c = r & 127; const float* uq = P.w_uq + (size_t)l * QL * 768 + h * 96; const float* uk = P.w_uk + (size_t)l * KVL * 512 + (size_t)c * 512 + h * 64;
                bf16* d = (bf16*)(wl + WL_WQS) + (size_t)r * QL;
#pragma unroll 1
                for (int m = 0; m < 4; ++m) { const int k = lane + 64 * m; float a = 0.f;
#pragma unroll 16
                    for (int n = 0; n < 64; n += 4) { const f32x4 x = *(const GAS f32x4*)(uq + (size_t)k * 768 + n), y = *(const GAS f32x4*)(uk + n); a += (x.x * y.x + x.y * y.y) + (x.z * y.z + x.w * y.w); }
                    d[k] = (bf16)f2bf(a); } }
            else { r -= I_QA;
                const size_t e0 = (size_t)r * 512 + 8 * lane; const float* src = P.w_sp + (size_t)l * 8 * 128 * 128 + e0; bf16* d = (bf16*)(wl + WL_WSP) + e0;
                const int i = (int)((e0 >> 7) & 127), j0 = (int)(e0 & 127);
                const f32x4 a = *(const GAS f32x4*)src, b2 = *(const GAS f32x4*)(src + 4); const float v[8] = {a.x, a.y, a.z, a.w, b2.x, b2.y, b2.z, b2.w};
                float m[8];
#pragma unroll
                for (int e = 0; e < 8; ++e) m[e] = (j0 + e <= i) ? v[e] : 0.f;
                v4u o; o.x = pk2(m[0], m[1]); o.y = pk2(m[2], m[3]); o.z = pk2(m[4], m[5]); o.w = pk2(m[6], m[7]); *(GAS v4u*)d = o; }
          }
          if (m0 < M) { const float* xr[4]; bf16* orow[4]; float* rsp[4]; bool valid[4];
#pragma unroll
            for (int r = 0; r < 4; ++r) { const int m = m0 + r * NGW; valid[r] = m < M; const int mm = valid[r] ? m : m0;
                xr[r] = mm < MP ? P.x_p + (size_t)mm * DM : P.x_s + (size_t)(mm - MP) * DM; orow[r] = Hb + (size_t)mm * DM; rsp[r] = RSb + mm; }
            rows_to_bf16_rs<4>(xr, orow, rsp, valid, lane); m0 += 4 * NGW; }
        }
        for (int e = gw * 64 + lane; e < NPOS * 16; e += NGW * 64) { const int pi = e >> 4, i = e & 15; const int pos = pi < SEQ ? pi : PAST + (pi - SEQ); float c, s; rope_entry(pos, i, c, s);
            *(GAS f32x2*)((float*)(P.ws + WS_ROPE) + (size_t)e * 2) = (f32x2){c, s}; }
    }
    SEAM(0);

    for (int l = 0; l < DEPTH; ++l) {
        const int pb = 1 + 9 * l;
        unsigned char* wl = P.ws + WS_WL + (size_t)l * WL_STRIDE;
        for (int rep_ = 0; rep_ < PHREP(1); ++rep_) if (PHEN(1) && IN(pb + 0)) {
            int ptid = threadIdx.x; asm volatile("" : "+v"(ptid)); const int lane = ptid & 63, wave = __builtin_amdgcn_readfirstlane(ptid >> 6), gw = vcu * NWAVES + wave; (void)lane; (void)gw;
            { SEpiBf16<0> E{Zb + (size_t)MP * ZW, ZW, nullptr}; for (int r3 = 0; r3 < PHREP(13); ++r3) mid_gemm(Hb + (size_t)MP * DM, DM, (const bf16*)(wl + WL_WIN), DM, DM, ZW / 64, 1, E, bx, G, (LAS char*)lds, ptid); }
            __syncthreads();
            pg8::Gemm g{Hb, (const bf16*)(wl + WL_WIN), DM, DM, DM}; pg8::StaticOrder S; S.init(MP / 256, ZW / 256, G, bx);
            pg8::EpiZ E{Zb, ZW, (float*)(P.ws + WS_SSQ), (float*)(P.ws + WS_SSV)};
            pg8::gemm_phase<pg8::EpiZ, pg8::StaticOrder, true, true>(lds + RING_OFF, g, S, E, ptid);
        }
        SEAM(pb + 0);
        if (PHEN(2) && IN(pb + 1)) {
            int ptid = threadIdx.x; asm volatile("" : "+v"(ptid)); const int lane = ptid & 63, wave = __builtin_amdgcn_readfirstlane(ptid >> 6), gw = vcu * NWAVES + wave; (void)lane; (void)gw; for (int m = gw; m < MP; m += 8 * NGW) { const int rows[8] = {m, m + NGW, m + 2 * NGW, m + 3 * NGW, m + 4 * NGW, m + 5 * NGW, m + 6 * NGW, m + 7 * NGW}; postproj_rows_ck<8>(P, l, rows, lane); }
            for (int m = MP + gw; m < M; m += NGW) postproj_row(P, l, m, lane); }
        SEAM(pb + 1);
        for (int rep_ = 0; rep_ < PHREP(3); ++rep_) if (PHEN(3) && IN(pb + 2)) {
            int ptid = threadIdx.x; asm volatile("" : "+v"(ptid)); const int lane = ptid & 63, wave = __builtin_amdgcn_readfirstlane(ptid >> 6), gw = vcu * NWAVES + wave; (void)lane; (void)gw;
#ifndef NO_C1
            { SEpiQs E{(bf16*)(P.ws + WS_QS), ropet, C2}; for (int r3 = 0; r3 < PHREP(13); ++r3) mid_gemm(Zb + (size_t)MP * ZW, ZW, (const bf16*)(wl + WL_WQS), QL, QL, 1280 / 64, 1, E, bx, G, (LAS char*)lds, ptid); }
#endif
            __syncthreads();
#ifndef NO_C2
            { pg8::Gemm g{Zb, (const bf16*)(wl + WL_WUQ), ZW, QL, QL}; pg8::StaticOrder S; S.init(MP / 256, 3, G, bx);
              pg8::EpiQ E{(bf16*)(P.ws + WS_QN), (bf16*)(P.ws + WS_QR), ropet, C2, SEQ - 1, (const float*)(P.ws + WS_SSQ)};
              pg8::gemm_phase<pg8::EpiQ, pg8::StaticOrder, true, true>(lds + RING_OFF, g, S, E, ptid); }
#endif
            __syncthreads();
#ifndef NO_C3
            { pg8::Gemm g{Zb + 256, (const bf16*)(wl + WL_WKV), ZW, KVL, KVL}; pg8::StaticOrder S; S.init(MP / 256, 4, G, bx);
              pg8::EpiBf16<0> E{(bf16*)(P.ws + WS_KV), 1024, nullptr};
              int ptid2 = threadIdx.x; asm volatile("" : "+v"(ptid2));
              pg8::gemm_phase<pg8::EpiBf16<0>, pg8::StaticOrder, true, true>(lds + RING_OFF, g, S, E, ptid2); }
#endif
        }
        SEAM(pb + 2);
        for (int rep_ = 0; rep_ < PHREP(4); ++rep_) if (PHEN(4) && IN(pb + 3)) {
            int ptid = threadIdx.x; asm volatile("" : "+v"(ptid)); const int lane = ptid & 63, wave = __builtin_amdgcn_readfirstlane(ptid >> 6), gw = vcu * NWAVES + wave; (void)lane; (void)gw;
            volatile LAS unsigned* qslot = (volatile LAS unsigned*)(lds + MISC_OFF) + 16;
            gu32* qheads = ctl + CW_Q + 64 * 8 * (l * 2 + rep_);
            constexpr int NLOC = DB / 8 + NB * NH + MP / CHUNK / 8;
            const unsigned myx = xb_xcc_id() & 7u; unsigned kk = 0u;
            for (;;) {
                if (ptid == 0) { unsigned id = 0xffffffffu, xq = myx;
                    while (kk < 8u) { xq = (myx + kk) & 7u; id = __hip_atomic_fetch_add(qheads + 64 * xq, 1u, RLX_AGENT); if (id < (unsigned)NLOC) break; id = 0xffffffffu; ++kk; }
                    qslot[0] = id; qslot[1] = xq; }
                __syncthreads();
                const unsigned idu = qslot[0]; const int xq = (int)qslot[1];
                __syncthreads();
                if (idu == 0xffffffffu) break;
                const int idx = (int)idu;
                int ja = -1;
                if (idx < 64) { if ((idx & 3) == 0) { if (!NO_SAMPLE) sample_unit(P, l, 16 * xq + (idx >> 2), (LAS char*)lds, ptid); } else ja = (idx >> 2) * 3 + (idx & 3) - 1; }
                else if (idx < 80) ja = idx - 16;
                else if (idx < 112) { if (!NO_GATE) gate_unit(P, l, 32 * xq + (idx - 80), (LAS char*)lds, ptid); }
                else ja = idx - 48;
                if (ja >= 0) { if (!NO_ATTN) attn_unit(P, 2 * xq + ((ja & 15) >> 3), ja & 7, 7 - (ja >> 4), (LAS char*)lds, ptid); }
            }
            __syncthreads();
        }
        SEAM(pb + 3);
        for (int rep_ = 0; rep_ < PHREP(5); ++rep_) if (PHEN(5) && IN(pb + 4)) {
            int ptid = threadIdx.x; asm volatile("" : "+v"(ptid)); const int lane = ptid & 63, wave = __builtin_amdgcn_readfirstlane(ptid >> 6), gw = vcu * NWAVES + wave; (void)lane; (void)gw;
            { SEpiBf16<0> E{MIXb + (size_t)MP * DM, DM, nullptr}; for (int r3 = 0; r3 < PHREP(13); ++r3) mid_gemm(AGb + (size_t)MP * DM, DM, (const bf16*)(wl + WL_WOUT), DM, DM, DM / 64, 1, E, bx, G, (LAS char*)lds, ptid); }
            __syncthreads();
            pg8::Gemm g{AGb, (const bf16*)(wl + WL_WOUT), DM, DM, DM}; pg8::StaticOrder S; S.init(MP / 256, DM / 256, G, bx);
            pg8::EpiBf16<0> E{MIXb, DM, nullptr};
            pg8::gemm_phase<pg8::EpiBf16<0>, pg8::StaticOrder, true, true>(lds + RING_OFF, g, S, E, ptid);
        }
        SEAM(pb + 4);
        for (int rep_ = 0; rep_ < ((l == 0) ? PHREP(6) : 1); ++rep_) if (PHEN(6) && IN(pb + 5)) {
            int ptid = threadIdx.x; asm volatile("" : "+v"(ptid)); const int lane = ptid & 63, wave = __builtin_amdgcn_readfirstlane(ptid >> 6), gw = vcu * NWAVES + wave; (void)lane; (void)gw;
            for (int m0 = gw; m0 < M; m0 += 2 * NGW) { RowIO io[2]; bool valid[2];
#pragma unroll
                for (int r = 0; r < 2; ++r) { const int m = m0 + r * NGW; valid[r] = m < M; const int mm = valid[r] ? m : m0;
                    io[r].xold = nullptr; io[r].xbold = Hb + (size_t)mm * DM;
                    io[r].trow = MIXb + (size_t)mm * DM; io[r].slab = nullptr; io[r].xnew = nullptr; io[r].xb = Hb + (size_t)mm * DM; io[r].rs = RSb + mm; }
                resid_rows<2>(io, valid, P.nm_post + l * DM, lane); }
        }
        SEAM(pb + 5);
        for (int rep_ = 0; rep_ < PHREP(7); ++rep_) if (PHEN(7) && IN(pb + 6)) {
            int ptid = threadIdx.x; asm volatile("" : "+v"(ptid)); const int lane = ptid & 63, wave = __builtin_amdgcn_readfirstlane(ptid >> 6), gw = vcu * NWAVES + wave; (void)lane; (void)gw;
            { SEpiBf16<2> E{Rb + (size_t)MP * DFF, DFF, nullptr}; for (int r3 = 0; r3 < PHREP(13); ++r3) mid_gemm(Hb + (size_t)MP * DM, DM, (const bf16*)(wl + WL_WUP), DM, DM, DFF / 64, 1, E, bx, G, (LAS char*)lds, ptid); }
            __syncthreads();
            pg8::Gemm g{Hb, (const bf16*)(wl + WL_WUP), DM, DM, DM}; pg8::StaticOrder S; S.init(MP / 256, DFF / 256, G, bx);
            pg8::EpiBf16<2> E{Rb, DFF, nullptr};
            pg8::gemm_phase<pg8::EpiBf16<2>, pg8::StaticOrder, true, true>(lds + RING_OFF, g, S, E, ptid);
        }
        SEAM(pb + 6);
        for (int rep_ = 0; rep_ < PHREP(8); ++rep_) if (PHEN(8) && IN(pb + 7)) {
            int ptid = threadIdx.x; asm volatile("" : "+v"(ptid)); const int lane = ptid & 63, wave = __builtin_amdgcn_readfirstlane(ptid >> 6), gw = vcu * NWAVES + wave; (void)lane; (void)gw;
            { SEpiF32Slab E{FSb}; for (int r3 = 0; r3 < PHREP(13); ++r3) mid_gemm(Rb + (size_t)MP * DFF, DFF, (const bf16*)(wl + WL_WDN), DFF, DFF / 4, DM / 64, 4, E, bx, G, (LAS char*)lds, ptid); }
            __syncthreads();
            pg8::Gemm g{Rb, (const bf16*)(wl + WL_WDN), DFF, DFF, DFF}; pg8::StaticOrder S; S.init(MP / 256, DM / 256, G, bx);
            pg8::EpiBf16<0> E{MIXb, DM, nullptr};
            pg8::gemm_phase<pg8::EpiBf16<0>, pg8::StaticOrder, true, true>(lds + RING_OFF, g, S, E, ptid);
        }
        SEAM(pb + 7);
        if (PHEN(9) && IN(pb + 8)) {
            int ptid = threadIdx.x; asm volatile("" : "+v"(ptid)); const int lane = ptid & 63, wave = __builtin_amdgcn_readfirstlane(ptid >> 6), gw = vcu * NWAVES + wave; (void)lane; (void)gw;
            for (int m0 = gw; m0 < M; m0 += 2 * NGW) { RowIO io[2]; bool valid[2];
#pragma unroll
                for (int r = 0; r < 2; ++r) { const int m = m0 + r * NGW; valid[r] = m < M; const int mm = valid[r] ? m : m0;
                    io[r].xold = nullptr; io[r].xbold = Hb + (size_t)mm * DM;
                    io[r].trow = mm < MP ? MIXb + (size_t)mm * DM : nullptr; io[r].slab = mm < MP ? nullptr : FSb + (size_t)(mm - MP) * DM;
                    io[r].xnew = (l + 1 < DEPTH) ? nullptr : P.out + (size_t)mm * DM; io[r].xb = (l + 1 < DEPTH) ? Hb + (size_t)mm * DM : nullptr; io[r].rs = RSb + mm; }
                resid_rows<2>(io, valid, P.nf_post + l * DM, lane); }
        }
        SEAM(pb + 8);
    }
    if (PROBE_PHASE >= 0 && bx == 0) { const unsigned long long now_ = __builtin_amdgcn_s_memrealtime(); if (PROBE_PHASE == N_PHASES - 1) pr_acc += now_ - pr_prev;
        const unsigned long long until_ = now_ + (unsigned long long)PROBE_MULT * pr_acc; while (__builtin_amdgcn_s_memrealtime() < until_) __builtin_amdgcn_s_sleep(32); }
#undef IN
#undef SEAM
}

extern "C" void kernel_launch(void* const* d_in, const int* in_sizes, int n_in, void* d_out, int out_size, void* d_ws, size_t ws_size, hipStream_t stream) {
    static int grid = 0;
    if (grid == 0) {
        if (n_in != 21 || (size_t)out_size != O_END || ws_size < WS_END) { fprintf(stderr, "kernel_launch: unexpected shapes: n_in %d out %d ws %zu (need %zu)\n", n_in, out_size, ws_size, (size_t)WS_END); grid = -1; return; }
        int dev = 0, cus = 0, per_cu = 0;
        if (hipGetDevice(&dev) != hipSuccess || hipDeviceGetAttribute(&cus, hipDeviceAttributeMultiprocessorCount, dev) != hipSuccess) { grid = -1; return; }
        if (hipFuncSetAttribute((const void*)fwd, hipFuncAttributeMaxDynamicSharedMemorySize, LDS_BYTES) != hipSuccess) { fprintf(stderr, "kernel_launch: hipFuncSetAttribute failed\n"); grid = -1; return; }
        if (hipOccupancyMaxActiveBlocksPerMultiprocessor(&per_cu, (const void*)fwd, NWAVES * 64, LDS_BYTES) != hipSuccess || per_cu < 1) fprintf(stderr, "kernel_launch: occupancy query reports %d\n", per_cu);
        (void)hipGetLastError();
        grid = cus;
    }
    if (grid < 0) return;
    if (hipMemsetAsync((char*)d_ws + WS_CTL, 0, CTL_ZERO_BYTES, stream) != hipSuccess) return;
    Args a{};
    Ptrs& p = a.p;
    p.x_p = (const float*)d_in[0]; p.x_s = (const float*)d_in[1]; p.cache_c = (const float*)d_in[2]; p.cache_r = (const float*)d_in[3]; p.ptab = (const int*)d_in[4];
    p.nm_pre = (const float*)d_in[5]; p.nm_post = (const float*)d_in[6]; p.w_in = (const float*)d_in[7]; p.q_norm = (const float*)d_in[8]; p.w_uq = (const float*)d_in[9];
    p.kv_norm = (const float*)d_in[10]; p.w_uk = (const float*)d_in[11]; p.w_uv = (const float*)d_in[12]; p.v_norm = (const float*)d_in[13]; p.w_sp = (const float*)d_in[14];
    p.b_sp = (const float*)d_in[15]; p.w_out = (const float*)d_in[16]; p.nf_pre = (const float*)d_in[17]; p.nf_post = (const float*)d_in[18]; p.w_up = (const float*)d_in[19]; p.w_dn = (const float*)d_in[20];
    p.out = (float*)d_out; p.ws = (unsigned char*)d_ws;
#if MK_ONE_LAUNCH
    a.ph_lo = 0; a.ph_hi = N_PHASES; a.one_launch = 1;
    hipLaunchKernelGGL(fwd, dim3(grid), dim3(NWAVES * 64), LDS_BYTES, stream, a);
#else
    for (int k = 0; k < N_PHASES; ++k) { a.ph_lo = k; a.ph_hi = k + 1; a.one_launch = 0;
        hipLaunchKernelGGL(fwd, dim3(grid), dim3(NWAVES * 64), LDS_BYTES, stream, a);
        if (hipPeekAtLastError() != hipSuccess) { fprintf(stderr, "kernel_launch: launch %d failed\n", k); break; } }
#endif
}
```
